# Optimizing an MI355X kernel written in HIP

```python
import jax, jax.numpy as jnp
from jax import lax
import numpy as np


D_MODEL = 1024
BATCH = 8
SEQ = 2048
DEPTH = 1
DEC_BATCH = 128
DEC_SEQ = 8
PAST_LEN = 16384
PAGE_SIZE = 128

GDN_HEADS = 8
GDN_DK = 128
GDN_DV = 128
GDN_QK_W = GDN_HEADS * GDN_DK
GDN_V_W = GDN_HEADS * GDN_DV
GDN_CONV = 4
GDN_CHUNK = 64
SC_W = D_MODEL
SC_CONV = 3
X_HEADS = 4
X_HEAD_DIM = D_MODEL // X_HEADS
N_MEM = 256
D_FF = 4 * D_MODEL
EPS = 1e-6
IN_SIZES = (GDN_QK_W, GDN_QK_W, GDN_V_W, GDN_V_W, GDN_HEADS, GDN_HEADS, SC_W, SC_W, SC_W, D_MODEL, D_MODEL)
IN_COLS = sum(IN_SIZES)
GDN_CONV_CH = 2 * GDN_QK_W + GDN_V_W

kernel_name = 'hybrid_gdn_shortconv_xattn_step'


def rmsnorm(x, w):
    xf = x.astype(jnp.float32)
    xf = xf * lax.rsqrt(jnp.mean(xf * xf, axis=-1, keepdims=True) + EPS)
    return (xf * w.astype(jnp.float32)).astype(x.dtype)


def l2norm(x):
    xf = x.astype(jnp.float32)
    return xf * lax.rsqrt(jnp.sum(xf * xf, axis=-1, keepdims=True) + EPS)


def causal_dwconv(x, buf, w):
    width = w.shape[0]
    T = x.shape[1]
    xx = jnp.concatenate([buf.astype(x.dtype), x], axis=1)
    y = xx[:, 0:T] * w[0]
    for i in range(1, width):
        y = y + xx[:, i:i + T] * w[i]
    return y, xx[:, xx.shape[1] - (width - 1):]


def split_cols(proj):
    idx = []
    acc = 0
    for s in IN_SIZES[:-1]:
        acc += s
        idx.append(acc)
    return jnp.split(proj, idx, axis=-1)


def gated_delta_rule(q, k, v, g, beta, S0):
    B, T, H, DK = q.shape
    DV = v.shape[-1]
    C = min(GDN_CHUNK, T)
    n = -(-T // C)
    pad = n * C - T
    q = jnp.pad(q, ((0, 0), (0, pad), (0, 0), (0, 0)))
    k = jnp.pad(k, ((0, 0), (0, pad), (0, 0), (0, 0)))
    v = jnp.pad(v, ((0, 0), (0, pad), (0, 0), (0, 0)))
    g = jnp.pad(g, ((0, 0), (0, pad), (0, 0)))
    beta = jnp.pad(beta, ((0, 0), (0, pad), (0, 0)))
    to_chunks4 = lambda t: t.reshape(B, n, C, H, t.shape[-1]).transpose(1, 0, 3, 2, 4)
    to_chunks3 = lambda t: t.reshape(B, n, C, H).transpose(1, 0, 3, 2)
    q, k, v = to_chunks4(q), to_chunks4(k), to_chunks4(v)
    g, beta = to_chunks3(g), to_chunks3(beta)
    gc = jnp.cumsum(g, axis=-1)
    incl = jnp.tril(jnp.ones((C, C), dtype=bool))
    strict = jnp.tril(jnp.ones((C, C), dtype=bool), -1)
    decay = jnp.exp(jnp.where(incl, gc[..., :, None] - gc[..., None, :], -jnp.inf))
    kk = jnp.einsum('nbhck,nbhdk->nbhcd', k, k)
    L = jnp.where(strict, beta[..., :, None] * kk * decay, 0.0)
    A = L + jnp.eye(C, dtype=L.dtype)
    kb_e = k * (beta * jnp.exp(gc))[..., None]
    vb = v * beta[..., None]
    W = lax.linalg.triangular_solve(A, kb_e, left_side=True, lower=True, unit_diagonal=True)
    Uv = lax.linalg.triangular_solve(A, vb, left_side=True, lower=True, unit_diagonal=True)
    P = jnp.einsum('nbhck,nbhdk->nbhcd', q, k) * decay
    q_e = q * jnp.exp(gc)[..., None]
    k_e = k * jnp.exp(gc[..., -1:] - gc)[..., None]
    g_tot = jnp.exp(gc[..., -1])

    def step(S, xs):
        W_c, Uv_c, P_c, qe_c, ke_c, gt_c = xs
        U = Uv_c - jnp.einsum('bhck,bhkv->bhcv', W_c, S)
        O = jnp.einsum('bhck,bhkv->bhcv', qe_c, S) + jnp.einsum('bhcd,bhdv->bhcv', P_c, U)
        S_new = gt_c[..., None, None] * S + jnp.einsum('bhck,bhcv->bhkv', ke_c, U)
        return S_new, O

    S_fin, O = lax.scan(step, S0, (W, Uv, P, q_e, k_e, g_tot))
    O = O.transpose(1, 0, 3, 2, 4).reshape(B, n * C, H, DV)[:, :T]
    return O, S_fin


def memory_kv(mem, mem_norm_w, w_xkv):
    B = mem.shape[0]
    kv = rmsnorm(mem, mem_norm_w) @ w_xkv
    mk, mv = jnp.split(kv, 2, axis=-1)
    return mk.reshape(B, N_MEM, X_HEADS, X_HEAD_DIM), mv.reshape(B, N_MEM, X_HEADS, X_HEAD_DIM)


def hybrid_layer(x, mem_k, mem_v, gdn_conv_buf, gdn_S, sc_buf,
                 norm_mix_w, w_in, gdn_conv_w, gdn_A_log, gdn_dt_bias, gdn_out_norm_w, w_gdn_o,
                 sc_conv_w, w_sc_o, w_mix_out, norm_x_w, w_xq, w_xo, norm_mlp_w, w_mlp_up, w_mlp_down):
    B, T, _ = x.shape
    f32 = jnp.float32
    h = rmsnorm(x, norm_mix_w)
    q, k, v, z, a, b, bg, cg, xin, ga, gb = split_cols(h @ w_in)
    qkv, new_gdn_conv_buf = causal_dwconv(jnp.concatenate([q, k, v], axis=-1), gdn_conv_buf, gdn_conv_w)
    qkv = jax.nn.silu(qkv)
    q, k, v = jnp.split(qkv, [GDN_QK_W, 2 * GDN_QK_W], axis=-1)
    q = l2norm(q.reshape(B, T, GDN_HEADS, GDN_DK)) * (GDN_DK ** -0.5)
    k = l2norm(k.reshape(B, T, GDN_HEADS, GDN_DK))
    v = v.reshape(B, T, GDN_HEADS, GDN_DV).astype(f32)
    g = -jnp.exp(gdn_A_log.astype(f32)) * jax.nn.softplus(a.astype(f32) + gdn_dt_bias.astype(f32))
    beta = jax.nn.sigmoid(b.astype(f32))
    o, new_S = gated_delta_rule(q, k, v, g, beta, gdn_S.astype(f32))
    o = rmsnorm(o, gdn_out_norm_w) * jax.nn.silu(z.reshape(B, T, GDN_HEADS, GDN_DV).astype(f32))
    y_a = o.reshape(B, T, GDN_V_W).astype(x.dtype) @ w_gdn_o
    u, new_sc_buf = causal_dwconv(cg * xin, sc_buf, sc_conv_w)
    y_b = (bg * u) @ w_sc_o
    merged = jax.nn.sigmoid(ga) * y_a + jax.nn.sigmoid(gb) * y_b
    x = x + merged @ w_mix_out
    hq = (rmsnorm(x, norm_x_w) @ w_xq).reshape(B, T, X_HEADS, X_HEAD_DIM)
    s = jnp.einsum('bthd,bshd->bhts', hq.astype(f32), mem_k.astype(f32)) * (X_HEAD_DIM ** -0.5)
    p = jax.nn.softmax(s, axis=-1)
    ctx = jnp.einsum('bhts,bshd->bthd', p, mem_v.astype(f32)).reshape(B, T, D_MODEL).astype(x.dtype)
    x = x + ctx @ w_xo
    hm = rmsnorm(x, norm_mlp_w) @ w_mlp_up
    x = x + jnp.square(jax.nn.relu(hm)) @ w_mlp_down
    return x, new_gdn_conv_buf, new_S.astype(gdn_S.dtype), new_sc_buf


def setup_inputs(seed: int = 0) -> dict:
    key = jax.random.key(seed)
    ks = iter(jax.random.split(key, 40))
    nk = lambda: next(ks)
    L = DEPTH
    w = lambda shape, fan_in: jax.random.normal(nk(), shape, jnp.float32) * (fan_in ** -0.5)
    gain = lambda shape: 1.0 + 0.02 * jax.random.normal(nk(), shape, jnp.float32)
    dt = jax.random.uniform(nk(), (L, GDN_HEADS), jnp.float32, minval=0.001, maxval=0.1)
    return {
        'x_prompt': jax.random.normal(nk(), (BATCH, SEQ, D_MODEL), jnp.float32),
        'x_sample': jax.random.normal(nk(), (DEC_BATCH, DEC_SEQ, D_MODEL), jnp.float32),
        'mem_prompt': jax.random.normal(nk(), (BATCH, N_MEM, D_MODEL), jnp.float32),
        'cache_mem_k': jax.random.normal(nk(), (L, DEC_BATCH, N_MEM, X_HEADS, X_HEAD_DIM), jnp.float32),
        'cache_mem_v': jax.random.normal(nk(), (L, DEC_BATCH, N_MEM, X_HEADS, X_HEAD_DIM), jnp.float32),
        'state_gdn_conv': jax.random.normal(nk(), (L, DEC_BATCH, GDN_CONV - 1, GDN_CONV_CH), jnp.float32),
        'state_gdn': 0.1 * jax.random.normal(nk(), (L, DEC_BATCH, GDN_HEADS, GDN_DK, GDN_DV), jnp.float32),
        'state_sc_conv': jax.random.normal(nk(), (L, DEC_BATCH, SC_CONV - 1, SC_W), jnp.float32),
        'norm_mix_w': gain((L, D_MODEL)),
        'w_in': w((L, D_MODEL, IN_COLS), D_MODEL),
        'gdn_conv_w': w((L, GDN_CONV, GDN_CONV_CH), GDN_CONV),
        'gdn_A_log': jnp.log(jax.random.uniform(nk(), (L, GDN_HEADS), jnp.float32, minval=1.0, maxval=16.0)),
        'gdn_dt_bias': jnp.log(jnp.expm1(dt)),
        'gdn_out_norm_w': gain((L, GDN_DV)),
        'w_gdn_o': w((L, GDN_V_W, D_MODEL), GDN_V_W),
        'sc_conv_w': w((L, SC_CONV, SC_W), SC_CONV),
        'w_sc_o': w((L, SC_W, D_MODEL), SC_W),
        'w_mix_out': w((L, D_MODEL, D_MODEL), D_MODEL),
        'norm_x_w': gain((L, D_MODEL)),
        'mem_norm_w': gain((L, D_MODEL)),
        'w_xq': w((L, D_MODEL, D_MODEL), D_MODEL),
        'w_xkv': w((L, D_MODEL, 2 * D_MODEL), D_MODEL),
        'w_xo': w((L, D_MODEL, D_MODEL), D_MODEL),
        'norm_mlp_w': gain((L, D_MODEL)),
        'w_mlp_up': w((L, D_MODEL, D_FF), D_MODEL),
        'w_mlp_down': w((L, D_FF, D_MODEL), D_FF),
        'norm_f_w': gain((D_MODEL,)),
    }


def reference(x_prompt, x_sample, mem_prompt, cache_mem_k, cache_mem_v, state_gdn_conv, state_gdn, state_sc_conv,
              norm_mix_w, w_in, gdn_conv_w, gdn_A_log, gdn_dt_bias, gdn_out_norm_w, w_gdn_o, sc_conv_w, w_sc_o,
              w_mix_out, norm_x_w, mem_norm_w, w_xq, w_xkv, w_xo, norm_mlp_w, w_mlp_up, w_mlp_down, norm_f_w):
    hp, hs = x_prompt, x_sample
    p_mk, p_mv, p_conv, p_S, p_sc = [], [], [], [], []
    s_conv, s_S, s_sc = [], [], []
    for i in range(DEPTH):
        lw = (norm_mix_w[i], w_in[i], gdn_conv_w[i], gdn_A_log[i], gdn_dt_bias[i], gdn_out_norm_w[i], w_gdn_o[i],
              sc_conv_w[i], w_sc_o[i], w_mix_out[i], norm_x_w[i], w_xq[i], w_xo[i], norm_mlp_w[i],
              w_mlp_up[i], w_mlp_down[i])
        mk, mv = memory_kv(mem_prompt, mem_norm_w[i], w_xkv[i])
        zero_conv = jnp.zeros((BATCH, GDN_CONV - 1, GDN_CONV_CH), hp.dtype)
        zero_S = jnp.zeros((BATCH, GDN_HEADS, GDN_DK, GDN_DV), state_gdn.dtype)
        zero_sc = jnp.zeros((BATCH, SC_CONV - 1, SC_W), hp.dtype)
        hp, pc, pS, psc = hybrid_layer(hp, mk, mv, zero_conv, zero_S, zero_sc, *lw)
        p_mk.append(mk)
        p_mv.append(mv)
        p_conv.append(pc)
        p_S.append(pS)
        p_sc.append(psc)
        hs, sc, sS, ssc = hybrid_layer(hs, cache_mem_k[i], cache_mem_v[i], state_gdn_conv[i], state_gdn[i],
                                       state_sc_conv[i], *lw)
        s_conv.append(sc)
        s_S.append(sS)
        s_sc.append(ssc)
    y_prompt = rmsnorm(hp, norm_f_w)
    y_sample = rmsnorm(hs, norm_f_w)
    return (y_prompt, y_sample,
            jnp.stack(p_mk), jnp.stack(p_mv), jnp.stack(p_conv), jnp.stack(p_S), jnp.stack(p_sc),
            jnp.stack(s_conv), jnp.stack(s_S), jnp.stack(s_sc))
```

```cpp
#include <hip/hip_runtime.h>
#include <cstdio>
#include <cstdint>
#include <cmath>

namespace pg8 {
#define PG8_LAS __attribute__((address_space(3)))
typedef unsigned short bf16_t;
typedef short bf16x8 __attribute__((ext_vector_type(8)));
typedef float f32x4 __attribute__((ext_vector_type(4)));
typedef unsigned u32x4 __attribute__((ext_vector_type(4)));
typedef unsigned u32x2 __attribute__((ext_vector_type(2)));
constexpr int BM = 256, BK = 64, HALF = 128, HTB = HALF * BK * 2, STAGE_BYTES = 8 * HTB, NXCD = 8, WGM = 8;

__host__ __device__ __forceinline__ int lds_byte(int r, int c) { const int st = (r >> 4) * 2 + (c >> 5), rr = r & 15, cc = c & 31, ob = rr * 64 + cc * 2; return st * 1024 + (ob ^ (((ob >> 9) & 1) << 5)); }
__host__ __device__ __forceinline__ void stage_rc(int b, int& R, int& C) { const int st = b / 1024, sb = b % 1024, swz = sb ^ (((sb >> 9) & 1) << 5); R = (st >> 1) * 16 + swz / 64; C = (st & 1) * 32 + (swz % 64) / 2; }
__host__ __device__ __forceinline__ int perm32(int rho) { const int n = rho >> 4, i = rho & 15; return 8 * (i >> 2) + 4 * n + (i & 3); }

struct Unit { int pm, pn, g; };
constexpr int MAXG = 4;
struct Probs { const unsigned char* base; PG8_LAS const unsigned* tab; int ng; int K; };
__device__ __forceinline__ int tabv(PG8_LAS const unsigned* tab, int i) { return __builtin_amdgcn_readfirstlane((int)tab[i]); }

struct GroupOrder {
    PG8_LAS const unsigned* tab; int ng, G, c;
    __device__ __forceinline__ void init(const Probs& P, int G_, int c_) { tab = P.tab; ng = P.ng; G = G_; c = c_; }
    __device__ __forceinline__ bool next(int i, Unit& u) const {
        int L = i * G + c; int g = -1, nm = 1, nn = 1, nwg = 1;
        for (int p = 0; p < ng; ++p) { const int a = tabv(tab, 8 + p), b = tabv(tab, 12 + p); if (L < a * b) { g = p; nm = a; nn = b; nwg = a * b; break; } L -= a * b; }
        if (g < 0) return false;
        int wgid = L; { const int q = nwg / NXCD, r = nwg % NXCD, xcd = wgid % NXCD, off = wgid / NXCD; wgid = (xcd < r ? xcd * (q + 1) : r * (q + 1) + (xcd - r) * q) + off; }
        const int nig = WGM * nn, gid = wgid / nig, fm = gid * WGM, gsz = (nm - fm) < WGM ? (nm - fm) : WGM;
        u.pm = fm + ((wgid % nig) % gsz); u.pn = (wgid % nig) / gsz; u.g = g; return true;
    }
};

__device__ __forceinline__ unsigned cvt_pk_bf16(float lo, float hi) { unsigned r; asm volatile("v_cvt_pk_bf16_f32 %0, %1, %2" : "=v"(r) : "v"(lo), "v"(hi)); return r; }

struct PairOrder {
    PG8_LAS const unsigned* tab; int ng, G, c;
    __device__ __forceinline__ void init(const Probs& P, int G_, int c_) { tab = P.tab; ng = P.ng; G = G_; c = c_; }
    __device__ __forceinline__ bool next(int i, Unit& u) const {
        const int nm = tabv(tab, 8), nn = tabv(tab, 12), nwg = nm * nn; const int L = (i >> 1) * G + c; if (L >= nwg) return false;
        int wgid = L; { const int q = nwg / NXCD, r = nwg % NXCD, xcd = wgid % NXCD, off = wgid / NXCD; wgid = (xcd < r ? xcd * (q + 1) : r * (q + 1) + (xcd - r) * q) + off; }
        const int nig = WGM * nn, gid = wgid / nig, fm = gid * WGM, gsz = (nm - fm) < WGM ? (nm - fm) : WGM;
        u.pm = fm + ((wgid % nig) % gsz); u.pn = (wgid % nig) / gsz; u.g = i & 1; return true;
    }
};

template <class Epi, class Sched>
__device__ __forceinline__ void gemm_phase(PG8_LAS unsigned char* lds, const Probs& P, const Sched& S, const Epi& E) {
    const int tid = threadIdx.x, wid = __builtin_amdgcn_readfirstlane(tid >> 6), lane = tid & 63, wr = wid >> 2, wc = wid & 3, fr = lane & 15, fq = lane >> 4;
    const int K = P.K, nt = K / BK;
    unsigned voffA[2], voffB[2];
#pragma unroll
    for (int i = 0; i < 2; ++i) { int R, C; stage_rc(tid * 16 + i * 8192, R, C); const int Rb = (R & ~31) + perm32(R & 31);
        voffA[i] = (unsigned)(R * K + C) * 2u; voffB[i] = (unsigned)(Rb * K + C) * 2u; }
    const size_t kstep = (size_t)(BK * 2);
    const size_t hstep = (size_t)HALF * K * 2;
    const size_t tstep = 2 * hstep;
    const unsigned ldsw = (unsigned)wid * 1024u;
    const int aoff = lds_byte(wr * 64 + fr, fq * 8), boff = lds_byte(wc * 32 + fr, fq * 8);
#define PG8_SA(b, h) (((b) * 2 + (h)) * HTB)
#define PG8_SB(b, h) ((4 + (b) * 2 + (h)) * HTB)
#define PG8_STAGE(bufoff, gbase, voff) do { _Pragma("unroll") for (int _i = 0; _i < 2; ++_i) \
        __builtin_amdgcn_global_load_lds((const unsigned*)((const char*)(gbase) + (voff)[_i]), (PG8_LAS unsigned*)(lds + (bufoff) + ldsw + _i * 8192), 16, 0, 0); } while (0)
#define PG8_LDA(dst, b, h) do { _Pragma("unroll") for (int m = 0; m < 4; ++m) _Pragma("unroll") for (int k = 0; k < 2; ++k) dst[m][k] = *(const PG8_LAS bf16x8*)(lds + PG8_SA(b, h) + aoff + m * 2048 + k * 1024); } while (0)
#define PG8_LDB(dst, b, h) do { _Pragma("unroll") for (int n = 0; n < 2; ++n) _Pragma("unroll") for (int k = 0; k < 2; ++k) dst[n][k] = *(const PG8_LAS bf16x8*)(lds + PG8_SB(b, h) + boff + n * 2048 + k * 1024); } while (0)
#define PG8_MMA(ai, bj, At, Bt) do { __builtin_amdgcn_s_setprio(1); _Pragma("unroll") for (int m = 0; m < 4; ++m) _Pragma("unroll") for (int n = 0; n < 2; ++n) _Pragma("unroll") for (int k = 0; k < 2; ++k) \
        acc[ai][bj][m][n] = __builtin_amdgcn_mfma_f32_16x16x32_bf16(Bt[n][k], At[m][k], acc[ai][bj][m][n], 0, 0, 0); __builtin_amdgcn_s_setprio(0); } while (0)
#define PG8_WAIT_V(n) asm volatile("s_waitcnt vmcnt(" #n ")" ::: "memory")
#define PG8_WAIT_L(n) asm volatile("s_waitcnt lgkmcnt(" #n ")" ::: "memory")
#define PG8_BAR __builtin_amdgcn_s_barrier()
#define PG8_SCHED __builtin_amdgcn_sched_barrier(0)
#define PG8_PA(u) ((const char*)P.base + (unsigned)tabv(P.tab, (u).g) + (size_t)(u).pm * tstep)
#define PG8_PB(u) ((const char*)P.base + (unsigned)tabv(P.tab, 4 + (u).g) + (size_t)(u).pn * tstep)
    Unit cur, nxt; int ui = 0;
    if (!S.next(0, cur)) return;
    f32x4 acc[2][2][4][2];
#pragma unroll
    for (int a = 0; a < 2; ++a)
#pragma unroll
        for (int b = 0; b < 2; ++b)
#pragma unroll
            for (int m = 0; m < 4; ++m)
#pragma unroll
                for (int n = 0; n < 2; ++n) acc[a][b][m][n] = (f32x4){0.f, 0.f, 0.f, 0.f};
    bf16x8 At[4][2], B0[2][2], B1[2][2];
    const char* cA = PG8_PA(cur); const char* cB = PG8_PB(cur);
    PG8_STAGE(PG8_SB(0, 0), cB, voffB); PG8_STAGE(PG8_SB(0, 1), cB + hstep, voffB); PG8_STAGE(PG8_SA(0, 0), cA, voffA); PG8_STAGE(PG8_SA(0, 1), cA + hstep, voffA);
    if (wr == 1) PG8_BAR;
    PG8_WAIT_V(2); PG8_BAR;
    PG8_STAGE(PG8_SB(1, 0), cB + kstep, voffB); PG8_STAGE(PG8_SA(1, 0), cA + kstep, voffA); PG8_STAGE(PG8_SB(1, 1), cB + hstep + kstep, voffB);
    PG8_WAIT_V(6); PG8_BAR;
    for (;;) {
        const bool has_next = S.next(ui + 1, nxt);
        const char* nA = cA; const char* nB = cB;
        if (has_next) { nA = PG8_PA(nxt); nB = PG8_PB(nxt); }
        for (int t = 0; t < nt; t += 2) {
            const bool last = (t == nt - 2);
            const char* a1 = cA + (size_t)(t + 1) * kstep;
            const char* a2 = last ? nA : cA + (size_t)(t + 2) * kstep; const char* b2 = last ? nB : cB + (size_t)(t + 2) * kstep;
            const char* a3 = a2 + kstep; const char* b3 = b2 + kstep;
            PG8_LDB(B0, 0, 0); PG8_LDB(B1, 0, 1); PG8_SCHED; PG8_LDA(At, 0, 0); PG8_STAGE(PG8_SA(1, 1), a1 + hstep, voffA);
            PG8_WAIT_V(8); PG8_WAIT_L(0); PG8_BAR; PG8_MMA(0, 0, At, B0); PG8_MMA(0, 1, At, B1); PG8_BAR; PG8_SCHED;
            PG8_LDA(At, 0, 1); PG8_STAGE(PG8_SB(0, 0), b2, voffB); PG8_STAGE(PG8_SB(0, 1), b2 + hstep, voffB); PG8_STAGE(PG8_SA(0, 0), a2, voffA);
            PG8_WAIT_V(8); PG8_WAIT_L(0); PG8_BAR; PG8_MMA(1, 0, At, B0); PG8_MMA(1, 1, At, B1); PG8_BAR; PG8_SCHED;
            PG8_LDB(B0, 1, 0); PG8_LDB(B1, 1, 1); PG8_SCHED; PG8_LDA(At, 1, 0); PG8_STAGE(PG8_SA(0, 1), a2 + hstep, voffA);
            PG8_WAIT_V(8); PG8_WAIT_L(0); PG8_BAR; PG8_MMA(0, 0, At, B0); PG8_MMA(0, 1, At, B1); PG8_BAR; PG8_SCHED;
            PG8_LDA(At, 1, 1); PG8_STAGE(PG8_SB(1, 0), b3, voffB); PG8_STAGE(PG8_SB(1, 1), b3 + hstep, voffB); PG8_STAGE(PG8_SA(1, 0), a3, voffA);
            PG8_WAIT_V(8); PG8_WAIT_L(0); PG8_BAR; PG8_MMA(1, 0, At, B0); PG8_MMA(1, 1, At, B1); PG8_BAR; PG8_SCHED;
        }
        if (wr == 0) PG8_BAR;
        E(acc, cur, wr, wc, fr, fq);
        if (!has_next) break;
#pragma unroll
        for (int a = 0; a < 2; ++a)
#pragma unroll
            for (int b = 0; b < 2; ++b)
#pragma unroll
                for (int m = 0; m < 4; ++m)
#pragma unroll
                    for (int n = 0; n < 2; ++n) acc[a][b][m][n] = (f32x4){0.f, 0.f, 0.f, 0.f};
        cur = nxt; cA = nA; cB = nB; ++ui;
        if (wr == 1) PG8_BAR;
    }
    PG8_WAIT_V(0);
    PG8_BAR;
#undef PG8_SA
#undef PG8_SB
#undef PG8_STAGE
#undef PG8_LDA
#undef PG8_LDB
#undef PG8_MMA
#undef PG8_WAIT_V
#undef PG8_WAIT_L
#undef PG8_BAR
#undef PG8_SCHED
#undef PG8_PA
#undef PG8_PB
}
}

constexpr int NWAVES = 8;
constexpr int D = 1024, NB = 8, SEQ = 2048, MP = NB * SEQ, DB = 128, DS = 8, MS = DB * DS, M = MP + MS;
constexpr int NH = 8, DK = 128, NMEM = 256, XH = 4, XD = 256, FF = 4096, NIN = 9232, NIN_T = 9216, MMEM = NB * NMEM;
constexpr float EPS = 1e-6f;
constexpr size_t O_Y = 0, O_MK = (size_t)M * D, O_MV = O_MK + (size_t)MMEM * D, O_GCP = O_MV + (size_t)MMEM * D, O_GSP = O_GCP + (size_t)NB * 3 * 3072,
                 O_SCP = O_GSP + (size_t)NB * NH * DK * DK, O_GCS = O_SCP + (size_t)NB * 2 * D, O_GSS = O_GCS + (size_t)DB * 3 * 3072, O_SCS = O_GSS + (size_t)DB * NH * DK * DK,
                 O_END = O_SCS + (size_t)DB * 2 * D;
static_assert(O_END == 41377792, "output size");

constexpr size_t MiB = 1u << 20;
constexpr size_t WS_CTL = 0, CTL_ZERO_BYTES = 1 * MiB;
constexpr size_t WS_WIN = 1 * MiB;
constexpr size_t WS_WGDNO = 19 * MiB, WS_WSCO = 21 * MiB, WS_WMIX = 23 * MiB, WS_WXQ = 25 * MiB, WS_WXO = 27 * MiB;
constexpr size_t WS_WXKV = 29 * MiB;
constexpr size_t WS_WUP = 33 * MiB;
constexpr size_t WS_WDN = 41 * MiB;
constexpr size_t WS_XN = 49 * MiB;
constexpr size_t WS_MN = 83 * MiB;
constexpr size_t WS_AB = 87 * MiB;
constexpr size_t WS_KB = 89 * MiB;
constexpr size_t WS_VT = 93 * MiB;
constexpr size_t WS_QKV = 97 * MiB;
constexpr size_t WS_UPRE = 199 * MiB, WS_SGA = 233 * MiB, WS_SGB = 267 * MiB;
constexpr size_t WS_R3 = 301 * MiB;
constexpr size_t WS_END = 445 * MiB;
constexpr size_t WS_YB = WS_QKV, WS_Q = WS_QKV, WS_MG = WS_R3, WS_CTX = WS_R3, WS_HB = WS_QKV;
constexpr size_t WS_SSQ = WS_SGA;
constexpr int CW_TMO = 0, CW_BAR = 4096;

#define GAS __attribute__((address_space(1)))
#define LAS __attribute__((address_space(3)))
typedef unsigned short bf16;
typedef unsigned v4u __attribute__((ext_vector_type(4)));
typedef unsigned v2u __attribute__((ext_vector_type(2)));
typedef float f32x4 __attribute__((ext_vector_type(4)));
typedef float f32x2 __attribute__((ext_vector_type(2)));
typedef short bf16x8 __attribute__((ext_vector_type(8)));
typedef __bf16 bf16x2_t __attribute__((ext_vector_type(2)));
typedef GAS unsigned gu32;
#define RLX_AGENT __ATOMIC_RELAXED, __HIP_MEMORY_SCOPE_AGENT
#define LDS_WAIT() asm volatile("s_waitcnt lgkmcnt(0)" ::: "memory")
#define VM_WAIT() asm volatile("s_waitcnt vmcnt(0)" ::: "memory")
__device__ __forceinline__ unsigned pk2(float lo, float hi) { f32x2 v = {lo, hi}; bf16x2_t b = __builtin_convertvector(v, bf16x2_t); return __builtin_bit_cast(unsigned, b); }
__device__ __forceinline__ float bf2f(unsigned short h) { return __uint_as_float((unsigned)h << 16); }
__device__ __forceinline__ float bflo(unsigned u) { return __uint_as_float(u << 16); }
__device__ __forceinline__ float bfhi(unsigned u) { return __uint_as_float(u & 0xffff0000u); }
__device__ __forceinline__ float sigmoidf_(float x) { return 1.f / (1.f + __expf(-x)); }
__device__ __forceinline__ float siluf_(float x) { return x / (1.f + __expf(-x)); }

#define XB_TMO      128
#define XB_XCNT(j)  (256  + 64 * (j))
#define XB_XSUB(j)  (1280 + 64 * (j))
#define XB_XGEN(j)  (2304 + 64 * (j))
#define XB_TOP      3328
#define XB_TOPGEN   3392
#define XCD_BAR_WORDS 3456
#define XB_SPIN_CAP (1u << 18)
__device__ __forceinline__ unsigned xb_ld(unsigned* p)              { return __hip_atomic_load(p, __ATOMIC_RELAXED, __HIP_MEMORY_SCOPE_AGENT); }
__device__ __forceinline__ unsigned xb_add(unsigned* p, unsigned v) { return __hip_atomic_fetch_add(p, v, __ATOMIC_RELAXED, __HIP_MEMORY_SCOPE_AGENT); }
__device__ __forceinline__ unsigned xb_xcc_id() { return (unsigned)__builtin_amdgcn_s_getreg((3 << 11) | 20) & 0xFu; }
#define XB_SPIN(cond, bar) do { unsigned _sp = 0; while (cond) { __builtin_amdgcn_s_sleep(1); \
    if ((++_sp & 255u) == 0u) { if (xb_ld(&(bar)[XB_TMO])) break; if (_sp > XB_SPIN_CAP) { atomicAdd(&(bar)[XB_TMO], 1u); break; } } } } while (0)
struct XcdBarrier { unsigned* bar; unsigned x; volatile LAS unsigned* st; };
__device__ __forceinline__ XcdBarrier xcd_barrier_post(unsigned* bar, volatile LAS unsigned* st) {
    XcdBarrier b; b.bar = bar; b.x = xb_xcc_id(); b.st = st;
    if (threadIdx.x == 0) (void)xb_add(&bar[XB_XCNT(b.x)], 1u);
    return b;
}
__device__ __forceinline__ void xcd_barrier_complete(unsigned* bar, unsigned x, unsigned& nloc, unsigned& nx) {
    const unsigned G = gridDim.x * gridDim.y * gridDim.z;
    unsigned sum, cnt, mine, sp = 0u;
    for (;;) {
        sum = 0u; cnt = 0u; mine = 0u;
#pragma unroll
        for (unsigned j = 0; j < 16; ++j) { const unsigned c = xb_ld(&bar[XB_XCNT(j)]); sum += c; cnt += (c > 0u) ? 1u : 0u; mine = (j == x) ? c : mine; }
        if (sum == G) break;
        __builtin_amdgcn_s_sleep(1);
        if ((++sp & 255u) == 0u) { if (xb_ld(&bar[XB_TMO])) break; if (sp > XB_SPIN_CAP) { atomicAdd(&bar[XB_TMO], 1u); break; } }
    }
    nloc = mine > 0u ? mine : 1u; nx = cnt > 0u ? cnt : 1u;
}
__device__ __forceinline__ void xcd_barrier(const XcdBarrier& b) {
    asm volatile("s_waitcnt vmcnt(0)" ::: "memory");
    __syncthreads();
    if (threadIdx.x == 0) {
        unsigned* bar = b.bar;
        __builtin_amdgcn_s_waitcnt(0);
        unsigned nloc = b.st[0], nx = b.st[1];
        if (nloc == 0u) { xcd_barrier_complete(bar, b.x, nloc, nx); b.st[0] = nloc; b.st[1] = nx; }
        const unsigned old = xb_add(&bar[XB_XSUB(b.x)], 1u);
        const unsigned gen = old / nloc;
        if (old + 1u == (gen + 1u) * nloc) {
            __builtin_amdgcn_fence(__ATOMIC_RELEASE, "agent");
            asm volatile("s_waitcnt vmcnt(0)" ::: "memory");
            const unsigned og = xb_add(&bar[XB_TOP], 1u);
            const unsigned tg = og / nx;
            if (og + 1u == (tg + 1u) * nx) xb_add(&bar[XB_TOPGEN], 1u);
            else XB_SPIN(xb_ld(&bar[XB_TOPGEN]) == tg, bar);
            __builtin_amdgcn_fence(__ATOMIC_ACQUIRE, "agent");
            xb_add(&bar[XB_XGEN(b.x)], 1u);
            asm volatile("s_waitcnt vmcnt(0)" ::: "memory");
        } else {
            XB_SPIN(xb_ld(&bar[XB_XGEN(b.x)]) == gen, bar);
            __builtin_amdgcn_fence(__ATOMIC_ACQUIRE, "agent");
            asm volatile("s_waitcnt vmcnt(0)" ::: "memory");
        }
    }
    __syncthreads();
}

constexpr int RING_OFF = 0, RING_BYTES = 131072;
constexpr int LDSCTL_OFF = RING_BYTES, MISC_OFF = LDSCTL_OFF + 320, TAB_OFF = LDSCTL_OFF + 64;
constexpr int LDS_BYTES = 147456;

struct Args {
    const float* in[27]; float* out; unsigned char* ws; int ph_lo, ph_hi, li, pad;
};
enum { I_XP = 0, I_XS, I_MEM, I_CK, I_CV, I_SGC, I_SG, I_SSC, I_NMIX, I_WIN, I_GCW, I_ALOG, I_DTB, I_GON, I_WGDNO, I_SCW, I_WSCO, I_WMIX, I_NX, I_NMEM, I_WXQ, I_WXKV, I_WXO, I_NMLP, I_WUP, I_WDN, I_NF };

struct Frame {
    LAS unsigned char* lds; volatile LAS unsigned* MISC; gu32* ctl;
    int tid, lane, wave, vcu, G;
    const float* const* in; float* out; unsigned char* ws;
};
__device__ __forceinline__ float wave_sum(float v) {
#pragma unroll
    for (int o = 1; o < 64; o <<= 1) v += __shfl_xor(v, o);
    return v;
}

__device__ __forceinline__ void p0_transpose_block(const float* W, int ldw, int K, int k0, int src_col, bf16* WT, int dst_row, LAS float* scr, int lane) {
#pragma unroll 8
    for (int i = 0; i < 32; ++i) { const int kk = 2 * i + (lane >> 5); scr[kk * 33 + (lane & 31)] = W[(size_t)(k0 + kk) * ldw + src_col + (lane & 31)]; }
    LDS_WAIT(); asm volatile("" ::: "memory");
    const int c = lane & 7;
#pragma unroll
    for (int j = 0; j < 4; ++j) { const int n = (lane >> 3) + 8 * j; const LAS float* s = scr + (8 * c) * 33 + n;
        v4u o; o.x = pk2(s[0 * 33], s[1 * 33]); o.y = pk2(s[2 * 33], s[3 * 33]); o.z = pk2(s[4 * 33], s[5 * 33]); o.w = pk2(s[6 * 33], s[7 * 33]);
        *(GAS v4u*)(WT + (size_t)(dst_row + n) * K + k0 + 8 * c) = o; }
    LDS_WAIT(); asm volatile("" ::: "memory");
}
__device__ __forceinline__ int win_src_col(int n) {
    if (n < 4096) return n;
    if (n < 5120) return 4112 + (n - 4096);
    if (n < 7168) { const int t = (n - 5120) >> 8, w = (n - 5120) & 255; return (w < 128) ? (5136 + 128 * t + w) : (6160 + 128 * t + (w - 128)); }
    if (n < 8192) return 7184 + (n - 7168);
    return 8208 + (n - 8192);
}
__device__ __forceinline__ void p0_prologue(Frame& F) {
    LAS float* scr = (LAS float*)(F.lds + RING_OFF + F.wave * 16384);
    const int gw = F.vcu * NWAVES + F.wave, NGW = F.G * NWAVES;
    unsigned char* ws = F.ws;
    constexpr int I_IN = 16 * (NIN_T / 32), I_SQ = 16 * 32, I_KV = 16 * 64, I_UP = 16 * 128, I_DN = 64 * 32;
    constexpr int NITEMS = I_IN + 5 * I_SQ + I_KV + I_UP + I_DN;
    for (int it = gw; it < NITEMS; it += NGW) {
        int r = it;
        if (r < I_IN) { const int nb = r % (NIN_T / 32), kb = r / (NIN_T / 32); p0_transpose_block(F.in[I_WIN], NIN, D, 64 * kb, win_src_col(32 * nb), (bf16*)(ws + WS_WIN), 32 * nb, scr, F.lane); continue; } r -= I_IN;
        bool done = false;
#pragma unroll
        for (int q = 0; q < 5; ++q) {
            if (!done && r < I_SQ) { const int idx = (q == 0) ? I_WGDNO : (q == 1) ? I_WSCO : (q == 2) ? I_WMIX : (q == 3) ? I_WXQ : I_WXO;
                const size_t off = (q == 0) ? WS_WGDNO : (q == 1) ? WS_WSCO : (q == 2) ? WS_WMIX : (q == 3) ? WS_WXQ : WS_WXO;
                const int nb = r % 32, kb = r / 32; p0_transpose_block(F.in[idx], D, D, 64 * kb, 32 * nb, (bf16*)(ws + off), 32 * nb, scr, F.lane); done = true; }
            if (!done) r -= I_SQ;
        }
        if (done) continue;
        if (r < I_KV) { const int nb = r % 64, kb = r / 64; p0_transpose_block(F.in[I_WXKV], 2 * D, D, 64 * kb, 32 * nb, (bf16*)(ws + WS_WXKV), 32 * nb, scr, F.lane); continue; } r -= I_KV;
        if (r < I_UP) { const int nb = r % 128, kb = r / 128; p0_transpose_block(F.in[I_WUP], FF, D, 64 * kb, 32 * nb, (bf16*)(ws + WS_WUP), 32 * nb, scr, F.lane); continue; } r -= I_UP;
        { const int nb = r % 32, kb = r / 32; p0_transpose_block(F.in[I_WDN], D, FF, 64 * kb, 32 * nb, (bf16*)(ws + WS_WDN), 32 * nb, scr, F.lane); }
    }
    __syncthreads();
    LAS float* wab = (LAS float*)(F.lds + RING_OFF);
    for (int e = F.tid; e < 1024 * 4; e += NWAVES * 64) { const int k = e >> 2, q4 = e & 3; const int rho = ((k >> 2) & 63) + 64 * ((k & 3) + 4 * (k >> 8));
        const f32x4 v = *(const GAS f32x4*)(F.in[I_WIN] + (size_t)k * NIN + 4096 + 4 * q4); *(LAS f32x4*)(wab + rho * 20 + 4 * q4) = v; }
    __syncthreads();
    const float* gmix = F.in[I_NMIX];
    f32x4 gw4[4];
#pragma unroll
    for (int j = 0; j < 4; ++j) gw4[j] = *(const GAS f32x4*)(gmix + 4 * F.lane + 256 * j);
    for (int m = gw; m < M; m += NGW) {
        const float* xrow = (m < MP) ? F.in[I_XP] + (size_t)m * D : F.in[I_XS] + (size_t)(m - MP) * D;
        const GAS f32x4* xr = (const GAS f32x4*)xrow + F.lane;
        f32x4 v[4]; float s = 0.f;
#pragma unroll
        for (int j = 0; j < 4; ++j) { v[j] = xr[64 * j]; s += (v[j].x * v[j].x + v[j].y * v[j].y) + (v[j].z * v[j].z + v[j].w * v[j].w); }
        const float rs = 1.f / sqrtf(wave_sum(s) * (1.f / D) + EPS);
#pragma unroll
        for (int j = 0; j < 4; ++j) v[j] = v[j] * rs * gw4[j];
        GAS v2u* o8 = (GAS v2u*)((bf16*)(ws + WS_XN) + (size_t)m * D) + F.lane;
#pragma unroll
        for (int j = 0; j < 4; ++j) { v2u o; o.x = pk2(v[j].x, v[j].y); o.y = pk2(v[j].z, v[j].w); o8[64 * j] = o; }
        float p[16];
#pragma unroll
        for (int o = 0; o < 16; ++o) p[o] = 0.f;
#pragma unroll
        for (int j = 0; j < 4; ++j)
#pragma unroll
            for (int e = 0; e < 4; ++e) { const float hv = v[j][e]; const LAS f32x4* wr = (const LAS f32x4*)(wab + (F.lane + 64 * (e + 4 * j)) * 20);
#pragma unroll
                for (int q4 = 0; q4 < 4; ++q4) { const f32x4 w = wr[q4]; p[4 * q4 + 0] += hv * w.x; p[4 * q4 + 1] += hv * w.y; p[4 * q4 + 2] += hv * w.z; p[4 * q4 + 3] += hv * w.w; }
                if (e & 1) asm volatile("" ::: "memory"); }
        float q8[8], q4v[4], q2[2], q1;
        { const bool hi = (F.lane & 32) != 0;
#pragma unroll
          for (int i = 0; i < 8; ++i) { const float send = hi ? p[i] : p[i + 8], keep = hi ? p[i + 8] : p[i]; q8[i] = keep + __shfl_xor(send, 32); } }
        { const bool hi = (F.lane & 16) != 0;
#pragma unroll
          for (int i = 0; i < 4; ++i) { const float send = hi ? q8[i] : q8[i + 4], keep = hi ? q8[i + 4] : q8[i]; q4v[i] = keep + __shfl_xor(send, 16); } }
        { const bool hi = (F.lane & 8) != 0;
#pragma unroll
          for (int i = 0; i < 2; ++i) { const float send = hi ? q4v[i] : q4v[i + 2], keep = hi ? q4v[i + 2] : q4v[i]; q2[i] = keep + __shfl_xor(send, 8); } }
        { const bool hi = (F.lane & 4) != 0; const float send = hi ? q2[0] : q2[1], keep = hi ? q2[1] : q2[0]; q1 = keep + __shfl_xor(send, 4); }
        q1 += __shfl_xor(q1, 2); q1 += __shfl_xor(q1, 1);
        if ((F.lane & 3) == 0) ((GAS float*)(ws + WS_AB))[(size_t)m * 16 + (F.lane >> 2)] = q1;
    }
    const float* gmem = F.in[I_NMEM];
#pragma unroll
    for (int j = 0; j < 4; ++j) gw4[j] = *(const GAS f32x4*)(gmem + 4 * F.lane + 256 * j);
    for (int m = gw; m < MMEM; m += NGW) {
        const GAS f32x4* xr = (const GAS f32x4*)(F.in[I_MEM] + (size_t)m * D) + F.lane;
        f32x4 v[4]; float s = 0.f;
#pragma unroll
        for (int j = 0; j < 4; ++j) { v[j] = xr[64 * j]; s += (v[j].x * v[j].x + v[j].y * v[j].y) + (v[j].z * v[j].z + v[j].w * v[j].w); }
        const float rs = 1.f / sqrtf(wave_sum(s) * (1.f / D) + EPS);
        GAS v2u* o8 = (GAS v2u*)((bf16*)(ws + WS_MN) + (size_t)m * D) + F.lane;
#pragma unroll
        for (int j = 0; j < 4; ++j) { const f32x4 h = v[j] * rs * gw4[j]; v2u o; o.x = pk2(h.x, h.y); o.y = pk2(h.z, h.w); o8[64 * j] = o; }
    }
    __syncthreads();
}

struct EpiP1 {
    unsigned char* ws; float* out;
    __device__ __forceinline__ void operator()(const pg8::f32x4 (&acc)[2][2][4][2], const pg8::Unit& u, int wr, int wc, int fr, int fq) const {
        bf16* const qkv = (bf16*)(ws + WS_QKV); bf16* const sz = (bf16*)(out + O_Y); bf16* const bg = sz + (size_t)M * D; bf16* const upre = (bf16*)(ws + WS_UPRE);
        bf16* const sga = (bf16*)(ws + WS_SGA); bf16* const sgb = (bf16*)(ws + WS_SGB); bf16* const kb = (bf16*)(ws + WS_KB); bf16* const vt = (bf16*)(ws + WS_VT);
        float* const mk = out + O_MK; float* const mv = out + O_MV;
        const int row0 = u.pm * 256 + wr * 64 + fr, cl = wc * 32 + 8 * fq;
        if (u.g == 0) {
            const int pn = u.pn;
            if (pn >= 20 && pn < 28) {
#pragma unroll
                for (int ai = 0; ai < 2; ++ai)
#pragma unroll
                    for (int m = 0; m < 4; ++m) { const size_t r = (size_t)(row0 + ai * 128 + m * 16);
                        const f32x4 a0 = acc[ai][0][m][0] * acc[ai][1][m][0], a1 = acc[ai][0][m][1] * acc[ai][1][m][1];
                        v4u w; w.x = pk2(a0[0], a0[1]); w.y = pk2(a0[2], a0[3]); w.z = pk2(a1[0], a1[1]); w.w = pk2(a1[2], a1[3]);
                        *(GAS v4u*)(upre + r * D + 128 * (pn - 20) + cl) = w; }
                return;
            }
            bf16* base; int ld, c0, act;
            if (pn < 12) { base = qkv; ld = 3072; c0 = 256 * pn; act = 0; }
            else if (pn < 16) { base = sz; ld = D; c0 = 256 * (pn - 12); act = 1; }
            else if (pn < 20) { base = bg; ld = D; c0 = 256 * (pn - 16); act = 0; }
            else if (pn < 32) { base = sga; ld = D; c0 = 256 * (pn - 28); act = 2; }
            else { base = sgb; ld = D; c0 = 256 * (pn - 32); act = 2; }
#pragma unroll
            for (int ai = 0; ai < 2; ++ai)
#pragma unroll
                for (int m = 0; m < 4; ++m) { bf16* rowp = base + (size_t)(row0 + ai * 128 + m * 16) * ld + c0 + cl;
#pragma unroll
                    for (int bj = 0; bj < 2; ++bj) { f32x4 v0 = acc[ai][bj][m][0], v1 = acc[ai][bj][m][1];
                        if (act == 1) {
#pragma unroll
                            for (int e = 0; e < 4; ++e) { v0[e] = siluf_(v0[e]); v1[e] = siluf_(v1[e]); } }
                        else if (act == 2) {
#pragma unroll
                            for (int e = 0; e < 4; ++e) { v0[e] = sigmoidf_(v0[e]); v1[e] = sigmoidf_(v1[e]); } }
                        v4u w; w.x = pk2(v0[0], v0[1]); w.y = pk2(v0[2], v0[3]); w.z = pk2(v1[0], v1[1]); w.w = pk2(v1[2], v1[3]);
                        *(GAS v4u*)(rowp + bj * 128) = w; } }
        } else if (u.g == 1) {
            const bool isk = u.pn < 4; float* fo = isk ? mk : mv; const int c0 = 256 * (u.pn & 3) + cl;
#pragma unroll
            for (int ai = 0; ai < 2; ++ai)
#pragma unroll
                for (int m = 0; m < 4; ++m) { const size_t r = (size_t)(row0 + ai * 128 + m * 16);
#pragma unroll
                    for (int bj = 0; bj < 2; ++bj) { const f32x4 v0 = acc[ai][bj][m][0], v1 = acc[ai][bj][m][1];
                        *(GAS f32x4*)(fo + r * D + c0 + bj * 128) = v0; *(GAS f32x4*)(fo + r * D + c0 + bj * 128 + 4) = v1;
                        if (isk) { v4u w; w.x = pk2(v0[0], v0[1]); w.y = pk2(v0[2], v0[3]); w.z = pk2(v1[0], v1[1]); w.w = pk2(v1[2], v1[3]);
                            *(GAS v4u*)(kb + r * D + c0 + bj * 128) = w; } } }
        } else {
#pragma unroll
            for (int ai = 0; ai < 2; ++ai)
#pragma unroll
                for (int m = 0; m < 4; ++m) { const size_t r = (size_t)(row0 + ai * 128 + m * 16);
#pragma unroll
                    for (int bj = 0; bj < 2; ++bj) { const int c = 256 * u.pn + bj * 128 + cl;
                        const int b3 = (c >> 3) & 1, cb = c & ~15; const f32x4 v0 = acc[ai][bj][m][0], v1 = acc[ai][bj][m][1];
                        v2u w0, w1; w0.x = pk2(v0[0], v0[1]); w0.y = pk2(v0[2], v0[3]); w1.x = pk2(v1[0], v1[1]); w1.y = pk2(v1[2], v1[3]);
                        *(GAS v2u*)(vt + r * MMEM + cb + 4 * b3) = w0; *(GAS v2u*)(vt + r * MMEM + cb + 8 + 4 * b3) = w1; } }
        }
    }
};


typedef float f32x16 __attribute__((ext_vector_type(16)));
#define MFMA32(a, b, c) __builtin_amdgcn_mfma_f32_32x32x16_bf16((a), (b), (c), 0, 0, 0)
__device__ __forceinline__ int crow(int reg, int h) { return (reg & 3) + 8 * (reg >> 2) + 4 * h; }
__device__ __forceinline__ bf16x8 pack_step(const f32x16& x, int s) {
    v4u p; p.x = pk2(x[8 * s + 0], x[8 * s + 1]); p.y = pk2(x[8 * s + 2], x[8 * s + 3]); p.z = pk2(x[8 * s + 4], x[8 * s + 5]); p.w = pk2(x[8 * s + 6], x[8 * s + 7]);
    return __builtin_bit_cast(bf16x8, p);
}
__device__ __forceinline__ float softplusf_(float x) { return x > 20.f ? x : log1pf(__expf(x)); }
constexpr int CH_W = 0, CH_QE = 16384, CH_KE = 32768, CH_UV = 49152, CH_P = 65536, CH_BYTES = 73728;
constexpr size_t WS_GT = WS_AB + 1536 * 1024;
constexpr size_t WS_O = WS_XN;
constexpr int PL_VF = 0, PL_KB = 32768, PL_QB = 50176, PL_LM = 67584, PL_GC = 83968, PL_BT = PL_GC + 256, PL_EG = PL_BT + 256;
constexpr int KBS = 136;

__device__ __forceinline__ void gdn_prep_unit(Frame& F, int u) {
    const int b = u >> 8, h = (u >> 5) & 7, c = u & 31;
    const size_t row0 = (size_t)b * SEQ + 64 * c;
    unsigned char* ws = F.ws;
    LAS float* vf = (LAS float*)(F.lds + PL_VF); LAS bf16* kb = (LAS bf16*)(F.lds + PL_KB); LAS bf16* qb = (LAS bf16*)(F.lds + PL_QB);
    LAS float* Lm = (LAS float*)(F.lds + PL_LM); LAS float* gcs = (LAS float*)(F.lds + PL_GC); LAS float* bts = (LAS float*)(F.lds + PL_BT); LAS float* egs = (LAS float*)(F.lds + PL_EG);
    unsigned char* rec = ws + WS_R3 + (size_t)u * CH_BYTES;
    const int lane = F.lane, w = F.wave;
    if (w == 0) {
        const float* ab = (const float*)(ws + WS_AB) + (row0 + lane) * 16;
        const float a = ab[h], bb = ab[8 + h];
        float g = -__expf(F.in[I_ALOG][h]) * softplusf_(a + F.in[I_DTB][h]);
        float gc = g;
#pragma unroll
        for (int o = 1; o < 64; o <<= 1) { const float t = __shfl_up(gc, o); if (lane >= o) gc += t; }
        gcs[lane] = gc; bts[lane] = sigmoidf_(bb); egs[lane] = __expf(gc);
    }
    __syncthreads();
    {
        const int cg = lane & 31, rp = lane >> 5, i0 = 8 * w + 4 * rp;
        const float gl = gcs[63];
        const bf16* qkv = (const bf16*)(ws + WS_QKV);
#pragma unroll
        for (int p = 0; p < 3; ++p) {
            const int colb = p * 1024 + h * 128 + 4 * cg;
            float x[7][4];
#pragma unroll
            for (int r = 0; r < 7; ++r) { const int t = 64 * c + i0 - 3 + r;
                v2u raw = {0u, 0u}; if (t >= 0) raw = *(const GAS v2u*)(qkv + (row0 + i0 - 3 + r) * 3072 + colb);
                x[r][0] = bflo(raw.x); x[r][1] = bfhi(raw.x); x[r][2] = bflo(raw.y); x[r][3] = bfhi(raw.y); }
            f32x4 wv[4];
#pragma unroll
            for (int i = 0; i < 4; ++i) wv[i] = *(const GAS f32x4*)(F.in[I_GCW] + (size_t)i * 3072 + colb);
            float y[4][4];
#pragma unroll
            for (int ro = 0; ro < 4; ++ro)
#pragma unroll
                for (int e = 0; e < 4; ++e) { float a = 0.f;
#pragma unroll
                    for (int i = 0; i < 4; ++i) a += wv[i][e] * x[ro + i][e];
                    y[ro][e] = siluf_(a); }
            if (p < 2) {
#pragma unroll
                for (int ro = 0; ro < 4; ++ro) { float ss = (y[ro][0] * y[ro][0] + y[ro][1] * y[ro][1]) + (y[ro][2] * y[ro][2] + y[ro][3] * y[ro][3]);
#pragma unroll
                    for (int o = 1; o < 32; o <<= 1) ss += __shfl_xor(ss, o);
                    const float sc = (1.f / sqrtf(ss + 1e-6f)) * (p == 0 ? 0.08838834764831845f : 1.f);
#pragma unroll
                    for (int e = 0; e < 4; ++e) y[ro][e] *= sc; }
            }
            if (p == 0) {
#pragma unroll
                for (int ro = 0; ro < 4; ++ro) { const int i = i0 + ro; v2u o; o.x = pk2(y[ro][0], y[ro][1]); o.y = pk2(y[ro][2], y[ro][3]);
                    *(LAS v2u*)(qb + i * KBS + 4 * cg) = o;
                    const float eg = egs[i]; v2u q; q.x = pk2(y[ro][0] * eg, y[ro][1] * eg); q.y = pk2(y[ro][2] * eg, y[ro][3] * eg);
                    const int rb = i >> 5, db = cg >> 3, s2 = (cg >> 2) & 1, a2 = (cg >> 1) & 1, hh = cg & 1;
                    *(GAS v2u*)(rec + CH_QE + ((((rb * 4 + db) * 2 + s2) * 64 + (i & 31) + 32 * hh) * 8 + 4 * a2) * 2) = q; }
            } else if (p == 1) {
#pragma unroll
                for (int ro = 0; ro < 4; ++ro) { const int i = i0 + ro; v2u o; o.x = pk2(y[ro][0], y[ro][1]); o.y = pk2(y[ro][2], y[ro][3]);
                    *(LAS v2u*)(kb + i * KBS + 4 * cg) = o; }
                float ek[4];
#pragma unroll
                for (int ro = 0; ro < 4; ++ro) ek[ro] = __expf(gl - gcs[i0 + ro]);
                const int rb = i0 >> 5, rho = i0 & 31, s2 = (rho >> 4) & 1, a2 = (rho >> 3) & 1, hh = (rho >> 2) & 1, db = cg >> 3;
#pragma unroll
                for (int e = 0; e < 4; ++e) { const int r = 4 * (cg & 7) + e; v2u o; o.x = pk2(y[0][e] * ek[0], y[1][e] * ek[1]); o.y = pk2(y[2][e] * ek[2], y[3][e] * ek[3]);
                    *(GAS v2u*)(rec + CH_KE + ((((db * 2 + rb) * 2 + s2) * 64 + r + 32 * hh) * 8 + 4 * a2) * 2) = o; }
            } else {
#pragma unroll
                for (int ro = 0; ro < 4; ++ro) *(LAS f32x4*)(vf + (i0 + ro) * 128 + 4 * cg) = (f32x4){y[ro][0], y[ro][1], y[ro][2], y[ro][3]};
            }
        }
    }
    __syncthreads();
    if ((w & 3) != 3) {
        const int tw = w & 3, ti = (tw == 0) ? 0 : 1, tj = (tw == 2) ? 1 : 0, r = lane & 31, hh = lane >> 5;
        const LAS bf16* bsrc = (w < 4) ? kb : qb;
        f32x16 acc;
#pragma unroll
        for (int i = 0; i < 16; ++i) acc[i] = 0.f;
#pragma unroll
        for (int s2 = 0; s2 < 8; ++s2) {
            const bf16x8 a = *(const LAS bf16x8*)(kb + (32 * tj + r) * KBS + 16 * s2 + 8 * hh);
            const bf16x8 bfr = *(const LAS bf16x8*)(bsrc + (32 * ti + r) * KBS + 16 * s2 + 8 * hh);
            acc = MFMA32(a, bfr, acc);
        }
        const int i = 32 * ti + r; const float gci = gcs[i], bi = bts[i];
        if (w < 4) {
#pragma unroll
            for (int g4 = 0; g4 < 4; ++g4) { f32x4 o;
#pragma unroll
                for (int e = 0; e < 4; ++e) { const int j = 32 * tj + crow(4 * g4 + e, hh); o[e] = (i > j) ? bi * acc[4 * g4 + e] * __expf(fminf(gci - gcs[j], 0.f)) : 0.f; }
                *(LAS f32x4*)(Lm + i * 64 + 32 * tj + 8 * g4 + 4 * hh) = o; }
        } else {
#pragma unroll
            for (int q = 0; q < 16; ++q) { const int j = 32 * tj + crow(q, hh); acc[q] = (i >= j) ? acc[q] * __expf(fminf(gci - gcs[j], 0.f)) : 0.f; }
#pragma unroll
            for (int s2 = 0; s2 < 2; ++s2) *(GAS bf16x8*)(rec + CH_P + (((ti * 2 + tj) * 2 + s2) * 64 + lane) * 16) = pack_step(acc, s2);
        }
    }
    __syncthreads();
    if (F.tid < 256) {
        const int cc = F.tid; float x[64];
        unsigned lmb = (unsigned)(size_t)Lm, kbb = (unsigned)(size_t)(kb + (cc & 127)), vfb = (unsigned)(size_t)(vf + (cc & 127)), btb = (unsigned)(size_t)bts;
        asm volatile("" : "+v"(lmb), "+v"(kbb), "+v"(vfb), "+v"(btb));
        LAS float* Lm = (LAS float*)lmb; LAS bf16* kb = (LAS bf16*)kbb - (cc & 127); LAS float* vf = (LAS float*)vfb - (cc & 127); LAS float* bts = (LAS float*)btb; LAS float* egs = bts + 64;
        if (cc < 128) {
#pragma unroll
            for (int i = 0; i < 64; ++i) x[i] = bf2f(kb[i * KBS + cc]) * bts[i] * egs[i];
        } else {
#pragma unroll
            for (int i = 0; i < 64; ++i) x[i] = vf[i * 128 + (cc - 128)] * bts[i];
        }
#pragma unroll
        for (int i = 1; i < 64; ++i) {
            float a0 = 0.f, a1 = 0.f;
#pragma unroll
            for (int j4 = 0; j4 < (i + 3) / 4; ++j4) { const f32x4 l = *(const LAS f32x4*)(Lm + i * 64 + 4 * j4);
#pragma unroll
                for (int e = 0; e < 4; ++e) { const int j = 4 * j4 + e; if (j < i) { if (e & 1) a1 += l[e] * x[j]; else a0 += l[e] * x[j]; } } }
            x[i] -= (a0 + a1);
            asm volatile("" ::: "memory");
        }
        if (cc < 128) {
#pragma unroll
            for (int i = 0; i < 64; ++i) kb[i * KBS + cc] = (bf16)(pk2(x[i], 0.f) & 0xffffu);
        } else {
#pragma unroll
            for (int i = 0; i < 64; ++i) vf[i * 128 + (cc - 128)] = x[i];
        }
    }
    __syncthreads();
#pragma unroll
    for (int k2 = 0; k2 < 2; ++k2) { const int pz = F.tid + 512 * k2, blk = pz >> 6, l2 = pz & 63, rb = blk >> 3, db = (blk >> 1) & 3, s2 = blk & 1, r = l2 & 31, hh = l2 >> 5;
        const LAS bf16* src = kb + (32 * rb + r) * KBS + 32 * db + 16 * s2 + 4 * hh;
        const v2u lo = *(const LAS v2u*)src, hi = *(const LAS v2u*)(src + 8);
        *(GAS v4u*)(rec + CH_W + (size_t)pz * 16) = (v4u){lo.x, lo.y, hi.x, hi.y}; }
#pragma unroll
    for (int k2 = 0; k2 < 4; ++k2) { const int pz = F.tid + 512 * k2, blk = pz >> 6, l2 = pz & 63, rb = blk >> 4, vsl = (blk >> 2) & 3, g4 = blk & 3, dvl = l2 & 31, hh = l2 >> 5;
        const LAS float* src = vf + (32 * rb + 8 * g4 + 4 * hh) * 128 + 32 * vsl + dvl;
        v2u o; o.x = pk2(src[0], src[128]); o.y = pk2(src[256], src[384]);
        *(GAS v2u*)(rec + CH_UV + (size_t)pz * 8) = o; }
    if (F.tid == 0) ((GAS float*)(ws + WS_GT))[u] = egs[63];
    __syncthreads();
}

__device__ __forceinline__ void gdn_sample_unit(Frame& F, int su) {
    const int sl = __builtin_amdgcn_readfirstlane(F.tid >> 7), cc = F.tid & 127, sq = 4 * su + sl, b = sq >> 3, h = sq & 7;
    unsigned char* ws = F.ws;
    LAS float* base = (LAS float*)(F.lds + sl * 16384);
    LAS float* qs = base, *ks = base + 1024, *vs = base + 2048, *egs = base + 3072, *bts = base + 3088;
    const bf16* qkv = (const bf16*)(ws + WS_QKV);
    const size_t rowb = (size_t)MP + (size_t)b * DS;
#pragma unroll
    for (int p = 0; p < 3; ++p) {
        const int col = p * 1024 + h * 128 + cc; float xx[11];
#pragma unroll
        for (int r = 0; r < 3; ++r) xx[r] = F.in[I_SGC][((size_t)b * 3 + r) * 3072 + col];
#pragma unroll
        for (int t = 0; t < 8; ++t) xx[3 + t] = bf2f(qkv[(rowb + t) * 3072 + col]);
        float wv[4];
#pragma unroll
        for (int i = 0; i < 4; ++i) wv[i] = F.in[I_GCW][(size_t)i * 3072 + col];
        LAS float* dst = (p == 0) ? qs : (p == 1) ? ks : vs;
#pragma unroll
        for (int t = 0; t < 8; ++t) { const float a = wv[0] * xx[t] + wv[1] * xx[t + 1] + wv[2] * xx[t + 2] + wv[3] * xx[t + 3]; dst[t * 128 + cc] = siluf_(a); }
    }
    if (cc < 8) { const float* ab = (const float*)(ws + WS_AB) + (rowb + cc) * 16;
        const float g = -__expf(F.in[I_ALOG][h]) * softplusf_(ab[h] + F.in[I_DTB][h]); egs[cc] = __expf(g); bts[cc] = sigmoidf_(ab[8 + h]); }
    float S[128];
    const float* s0 = F.in[I_SG] + ((size_t)(b * 8 + h) * 128) * 128 + cc;
#pragma unroll
    for (int dk = 0; dk < 128; ++dk) S[dk] = s0[(size_t)dk * 128];
    __syncthreads();
    for (int t = 0; t < 8; ++t) {
        float ssk = 0.f, kS = 0.f;
#pragma unroll
        for (int d4 = 0; d4 < 32; ++d4) { const f32x4 kv = *(const LAS f32x4*)(ks + t * 128 + 4 * d4);
#pragma unroll
            for (int e = 0; e < 4; ++e) { ssk += kv[e] * kv[e]; kS += S[4 * d4 + e] * kv[e]; }
            if ((d4 & 3) == 3) asm volatile("" ::: "memory"); }
        const float rk = 1.f / sqrtf(ssk + 1e-6f), eg = egs[t];
        const float uu = bts[t] * (vs[t * 128 + cc] - eg * kS * rk) * rk;
        float ssq = 0.f, o = 0.f;
#pragma unroll
        for (int d4 = 0; d4 < 32; ++d4) { const f32x4 kv = *(const LAS f32x4*)(ks + t * 128 + 4 * d4); const f32x4 qv = *(const LAS f32x4*)(qs + t * 128 + 4 * d4);
#pragma unroll
            for (int e = 0; e < 4; ++e) { const float sn = eg * S[4 * d4 + e] + kv[e] * uu; S[4 * d4 + e] = sn; ssq += qv[e] * qv[e]; o += sn * qv[e]; }
            if ((d4 & 1) == 1) asm volatile("" ::: "memory"); }
        o *= (1.f / sqrtf(ssq + 1e-6f)) * 0.08838834764831845f;
        ((bf16*)(ws + WS_O))[(rowb + t) * D + h * 128 + cc] = (bf16)(pk2(o, 0.f) & 0xffffu);
    }
    float* so = F.out + O_GSS + ((size_t)(b * 8 + h) * 128) * 128 + cc;
#pragma unroll
    for (int dk = 0; dk < 128; ++dk) so[(size_t)dk * 128] = S[dk];
    __syncthreads();
}

__device__ __forceinline__ void sc_conv_pass(Frame& F) {
    const bf16* upre = (const bf16*)(F.ws + WS_UPRE); bf16* bgp = (bf16*)(F.out + O_Y) + (size_t)M * D;
    const size_t gt = (size_t)F.vcu * (NWAVES * 64) + F.tid, NT = (size_t)F.G * NWAVES * 64;
    for (size_t it = gt; it < (size_t)M * 128; it += NT) {
        const size_t row = it >> 7; const int c8 = (int)(it & 127) * 8;
        const bool smp = row >= MP; const int t = smp ? (int)((row - MP) & 7) : (int)(row & (SEQ - 1)); const int sb = smp ? (int)((row - MP) >> 3) : 0;
        float xm[3][8];
        { const v4u r = *(const GAS v4u*)(upre + row * D + c8); xm[2][0] = bflo(r.x); xm[2][1] = bfhi(r.x); xm[2][2] = bflo(r.y); xm[2][3] = bfhi(r.y); xm[2][4] = bflo(r.z); xm[2][5] = bfhi(r.z); xm[2][6] = bflo(r.w); xm[2][7] = bfhi(r.w); }
#pragma unroll
        for (int k = 1; k <= 2; ++k) {
            if (t - k >= 0) { const v4u r = *(const GAS v4u*)(upre + (row - k) * D + c8);
                xm[2 - k][0] = bflo(r.x); xm[2 - k][1] = bfhi(r.x); xm[2 - k][2] = bflo(r.y); xm[2 - k][3] = bfhi(r.y); xm[2 - k][4] = bflo(r.z); xm[2 - k][5] = bfhi(r.z); xm[2 - k][6] = bflo(r.w); xm[2 - k][7] = bfhi(r.w); }
            else if (smp) { const float* sp = F.in[I_SSC] + ((size_t)sb * 2 + (2 + t - k)) * D + c8;
#pragma unroll
                for (int e = 0; e < 8; ++e) xm[2 - k][e] = sp[e]; }
            else {
#pragma unroll
                for (int e = 0; e < 8; ++e) xm[2 - k][e] = 0.f; }
        }
        const v4u br = *(const GAS v4u*)(bgp + row * D + c8);
        float bgv[8] = {bflo(br.x), bfhi(br.x), bflo(br.y), bfhi(br.y), bflo(br.z), bfhi(br.z), bflo(br.w), bfhi(br.w)};
        float o[8];
#pragma unroll
        for (int e = 0; e < 8; ++e) { const float w0 = F.in[I_SCW][c8 + e], w1 = F.in[I_SCW][D + c8 + e], w2 = F.in[I_SCW][2 * D + c8 + e];
            o[e] = bgv[e] * (w0 * xm[0][e] + w1 * xm[1][e] + w2 * xm[2][e]); }
        *(GAS v4u*)(bgp + row * D + c8) = (v4u){pk2(o[0], o[1]), pk2(o[2], o[3]), pk2(o[4], o[5]), pk2(o[6], o[7])};
    }
}

__device__ __forceinline__ void gdn_scan_wave(Frame& F, int bh, int vsl) {
    unsigned char* ws = F.ws; const int lane = F.lane, dvl = lane & 31, hh = lane >> 5;
    f32x16 S[4];
#pragma unroll
    for (int d = 0; d < 4; ++d)
#pragma unroll
        for (int i = 0; i < 16; ++i) S[d][i] = 0.f;
    const int b = bh >> 3, h = bh & 7;
    const unsigned l16 = (unsigned)lane * 16u, uvo = (unsigned)(vsl * 4 * 512 + lane * 8);
    bf16* Og = (bf16*)(ws + WS_O);
    for (int c = 0; c < 32; ++c) {
        const int u = bh * 32 + c;
        const unsigned char* rec = ws + WS_R3 + (size_t)u * CH_BYTES;
        const float gt = ((const GAS float*)(ws + WS_GT))[u];
        bf16x8 Sb[4][2];
#pragma unroll
        for (int d = 0; d < 4; ++d) { Sb[d][0] = pack_step(S[d], 0); Sb[d][1] = pack_step(S[d], 1); }
        f32x16 U[2];
#pragma unroll
        for (int rb = 0; rb < 2; ++rb) {
            f32x16 a;
#pragma unroll
            for (int i = 0; i < 16; ++i) a[i] = 0.f;
#pragma unroll
            for (int d = 0; d < 4; ++d) {
#pragma unroll
                for (int s2 = 0; s2 < 2; ++s2) a = MFMA32(*(const GAS bf16x8*)(rec + (CH_W + ((rb * 4 + d) * 2 + s2) * 1024) + l16), Sb[d][s2], a);
                if (d == 1) asm volatile("" ::: "memory"); }
#pragma unroll
            for (int g4 = 0; g4 < 4; ++g4) { const v2u uv = *(const GAS v2u*)(rec + (CH_UV + (rb * 4 * 4 + g4) * 512) + uvo);
                a[4 * g4 + 0] = bflo(uv.x) - a[4 * g4 + 0]; a[4 * g4 + 1] = bfhi(uv.x) - a[4 * g4 + 1]; a[4 * g4 + 2] = bflo(uv.y) - a[4 * g4 + 2]; a[4 * g4 + 3] = bfhi(uv.y) - a[4 * g4 + 3]; }
            U[rb] = a;
            asm volatile("" ::: "memory");
        }
        bf16x8 Ub[2][2];
#pragma unroll
        for (int rb = 0; rb < 2; ++rb) { Ub[rb][0] = pack_step(U[rb], 0); Ub[rb][1] = pack_step(U[rb], 1); }
#pragma unroll
        for (int rb = 0; rb < 2; ++rb) {
            f32x16 o;
#pragma unroll
            for (int i = 0; i < 16; ++i) o[i] = 0.f;
#pragma unroll
            for (int d = 0; d < 4; ++d) {
#pragma unroll
                for (int s2 = 0; s2 < 2; ++s2) o = MFMA32(*(const GAS bf16x8*)(rec + (CH_QE + ((rb * 4 + d) * 2 + s2) * 1024) + l16), Sb[d][s2], o);
                if (d == 1) asm volatile("" ::: "memory"); }
#pragma unroll
            for (int tj = 0; tj < 2; ++tj) if (tj <= rb)
#pragma unroll
                for (int s2 = 0; s2 < 2; ++s2) o = MFMA32(*(const GAS bf16x8*)(rec + (CH_P + ((rb * 2 + tj) * 2 + s2) * 1024) + l16), Ub[tj][s2], o);
            bf16* op = Og + ((size_t)b * SEQ + 64 * c + 32 * rb) * D + h * 128 + 32 * vsl + dvl;
#pragma unroll
            for (int q = 0; q < 16; ++q) op[(size_t)crow(q, hh) * D] = (bf16)(pk2(o[q], 0.f) & 0xffffu);
            asm volatile("" ::: "memory");
        }
#pragma unroll
        for (int d = 0; d < 4; ++d) {
            f32x16 a = S[d] * gt;
#pragma unroll
            for (int rb = 0; rb < 2; ++rb)
#pragma unroll
                for (int s2 = 0; s2 < 2; ++s2) a = MFMA32(*(const GAS bf16x8*)(rec + (CH_KE + ((d * 2 + rb) * 2 + s2) * 1024) + l16), Ub[rb][s2], a);
            S[d] = a;
            asm volatile("" ::: "memory");
        }
    }
    float* so = F.out + O_GSP + ((size_t)bh * 128) * 128 + 32 * vsl + dvl;
#pragma unroll
    for (int d = 0; d < 4; ++d)
#pragma unroll
        for (int q = 0; q < 16; ++q) so[(size_t)(32 * d + crow(q, hh)) * 128] = S[d][q];
}

__device__ __forceinline__ void og_pass(Frame& F) {
    bf16* Og = (bf16*)(F.ws + WS_O); const bf16* sz = (const bf16*)(F.out + O_Y);
    const int gw = F.vcu * NWAVES + F.wave, NGW = F.G * NWAVES;
    const float w0 = F.in[I_GON][2 * F.lane], w1 = F.in[I_GON][2 * F.lane + 1];
    for (int m = gw; m < M; m += NGW) {
        unsigned ov[8], zv[8];
#pragma unroll
        for (int hd = 0; hd < 8; ++hd) { ov[hd] = *(const GAS unsigned*)(Og + (size_t)m * D + hd * 128 + 2 * F.lane); zv[hd] = *(const GAS unsigned*)(sz + (size_t)m * D + hd * 128 + 2 * F.lane); }
#pragma unroll
        for (int hd = 0; hd < 8; ++hd) { const float a = bflo(ov[hd]), bq = bfhi(ov[hd]);
            const float rs = 1.f / sqrtf(wave_sum(a * a + bq * bq) * (1.f / 128.f) + EPS);
            *(GAS unsigned*)(Og + (size_t)m * D + hd * 128 + 2 * F.lane) = pk2(a * rs * w0 * bflo(zv[hd]), bq * rs * w1 * bfhi(zv[hd])); }
    }
}


__device__ __forceinline__ void unpack8(const v4u r, float (&o)[8]) { o[0] = bflo(r.x); o[1] = bfhi(r.x); o[2] = bflo(r.y); o[3] = bfhi(r.y); o[4] = bflo(r.z); o[5] = bfhi(r.z); o[6] = bflo(r.w); o[7] = bfhi(r.w); }
struct EpiP3 {
    unsigned char* ws;
    __device__ __forceinline__ void operator()(const pg8::f32x4 (&acc)[2][2][4][2], const pg8::Unit& u, int wr, int wc, int fr, int fq) const {
        const bf16* gate = (const bf16*)(ws + (u.g == 0 ? WS_SGB : WS_SGA)); bf16* yb = (bf16*)(ws + WS_YB); bf16* mg = (bf16*)(ws + WS_MG);
        const int row0 = u.pm * 256 + wr * 64 + fr, col0 = u.pn * 256 + wc * 32 + 8 * fq;
#pragma unroll
        for (int ai = 0; ai < 2; ++ai)
#pragma unroll
            for (int m = 0; m < 4; ++m) { const size_t ro = (size_t)(row0 + ai * 128 + m * 16) * D + col0;
#pragma unroll
                for (int bj = 0; bj < 2; ++bj) { float gv[8]; unpack8(*(const GAS v4u*)(gate + ro + bj * 128), gv);
                    float v[8];
#pragma unroll
                    for (int e = 0; e < 4; ++e) { v[e] = acc[ai][bj][m][0][e] * gv[e]; v[4 + e] = acc[ai][bj][m][1][e] * gv[4 + e]; }
                    if (u.g == 1) { float y[8]; unpack8(*(const GAS v4u*)(yb + ro + bj * 128), y);
#pragma unroll
                        for (int e = 0; e < 8; ++e) v[e] += y[e]; }
                    const v4u w = {pk2(v[0], v[1]), pk2(v[2], v[3]), pk2(v[4], v[5]), pk2(v[6], v[7])};
                    *(GAS v4u*)((u.g == 0 ? yb : mg) + ro + bj * 128) = w; } }
    }
};
template <bool FIRST> struct EpiRes {
    const float* xp; const float* xsmp; float* xo; const float* gain; bf16* an; float* ssq; bool write_a;
    __device__ __forceinline__ void operator()(const pg8::f32x4 (&acc)[2][2][4][2], const pg8::Unit& u, int wr, int wc, int fr, int fq) const {
        const int row0 = u.pm * 256 + wr * 64 + fr, col0 = u.pn * 256 + wc * 32 + 8 * fq;
        f32x4 gv[2][2];
#pragma unroll
        for (int bj = 0; bj < 2; ++bj) { gv[bj][0] = *(const GAS f32x4*)(gain + col0 + bj * 128); gv[bj][1] = *(const GAS f32x4*)(gain + col0 + bj * 128 + 4); }
#pragma unroll
        for (int ai = 0; ai < 2; ++ai)
#pragma unroll
            for (int m = 0; m < 4; ++m) { const int row = row0 + ai * 128 + m * 16; const size_t ro = (size_t)row * D + col0;
                const float* src = FIRST ? ((row < MP) ? xp + ro : xsmp + (ro - (size_t)MP * D)) : xo + ro;
                float ss = 0.f;
#pragma unroll
                for (int bj = 0; bj < 2; ++bj) {
                    const f32x4 x0 = *(const GAS f32x4*)(src + bj * 128) + acc[ai][bj][m][0], x1 = *(const GAS f32x4*)(src + bj * 128 + 4) + acc[ai][bj][m][1];
                    *(GAS f32x4*)(xo + ro + bj * 128) = x0; *(GAS f32x4*)(xo + ro + bj * 128 + 4) = x1;
                    ss += (x0[0] * x0[0] + x0[1] * x0[1]) + (x0[2] * x0[2] + x0[3] * x0[3]) + (x1[0] * x1[0] + x1[1] * x1[1]) + (x1[2] * x1[2] + x1[3] * x1[3]);
                    if (write_a) { const f32x4 a0 = x0 * gv[bj][0], a1 = x1 * gv[bj][1];
                        *(GAS v4u*)(an + ro + bj * 128) = (v4u){pk2(a0[0], a0[1]), pk2(a0[2], a0[3]), pk2(a1[0], a1[1]), pk2(a1[2], a1[3])}; } }
                ss += __shfl_xor(ss, 16); ss += __shfl_xor(ss, 32);
                if (fq == 0) ssq[(size_t)row * 16 + u.pn * 4 + wc] = ss; }
    }
};
__device__ __forceinline__ float row_rs(const float* ssq, int row) {
    const f32x4 a = *(const GAS f32x4*)(ssq + (size_t)row * 16), b = *(const GAS f32x4*)(ssq + (size_t)row * 16 + 4), c = *(const GAS f32x4*)(ssq + (size_t)row * 16 + 8), d = *(const GAS f32x4*)(ssq + (size_t)row * 16 + 12);
    const float s = ((a[0] + a[1]) + (a[2] + a[3])) + ((b[0] + b[1]) + (b[2] + b[3])) + ((c[0] + c[1]) + (c[2] + c[3])) + ((d[0] + d[1]) + (d[2] + d[3]));
    return 1.f / sqrtf(s * (1.f / D) + EPS);
}
template <int ACT> struct EpiScale {
    const float* ssq; bf16* o; int ldc; float scale;
    __device__ __forceinline__ void operator()(const pg8::f32x4 (&acc)[2][2][4][2], const pg8::Unit& u, int wr, int wc, int fr, int fq) const {
        const int row0 = u.pm * 256 + wr * 64 + fr, col0 = u.pn * 256 + wc * 32 + 8 * fq;
#pragma unroll
        for (int ai = 0; ai < 2; ++ai)
#pragma unroll
            for (int m = 0; m < 4; ++m) { const int row = row0 + ai * 128 + m * 16; const float rs = row_rs(ssq, row) * scale;
#pragma unroll
                for (int bj = 0; bj < 2; ++bj) { f32x4 v0 = acc[ai][bj][m][0] * rs, v1 = acc[ai][bj][m][1] * rs;
                    if (ACT == 1) {
#pragma unroll
                        for (int e = 0; e < 4; ++e) { const float a = fmaxf(v0[e], 0.f), b = fmaxf(v1[e], 0.f); v0[e] = a * a; v1[e] = b * b; } }
                    *(GAS v4u*)(o + (size_t)row * ldc + col0 + bj * 128) = (v4u){pk2(v0[0], v0[1]), pk2(v0[2], v0[3]), pk2(v1[0], v1[1]), pk2(v1[2], v1[3])}; } }
    }
};

__device__ __forceinline__ void attn_prompt_unit(Frame& F, int u) {
    unsigned char* ws = F.ws; const int lane = F.lane, r = lane & 31, hh = lane >> 5;
    const int qt = u & 7, head = (u >> 3) & 3, b = u >> 5;
    const size_t row0 = (size_t)b * SEQ + qt * 256 + 32 * F.wave;
    const bf16* Q = (const bf16*)(ws + WS_Q) + (row0 + r) * D + head * 256 + 8 * hh;
    const bf16* Kp = (const bf16*)(ws + WS_KB) + ((size_t)b * NMEM + r) * D + head * 256 + 8 * hh;
    const bf16* Vp = (const bf16*)(ws + WS_VT) + ((size_t)head * 256 + r) * MMEM + (size_t)b * NMEM + 8 * hh;
    f32x16 acc[8];
#pragma unroll
    for (int kt = 0; kt < 8; ++kt)
#pragma unroll
        for (int i = 0; i < 16; ++i) acc[kt][i] = 0.f;
#pragma unroll
    for (int s2 = 0; s2 < 16; ++s2) {
        const bf16x8 bq = *(const GAS bf16x8*)(Q + 16 * s2);
#pragma unroll
        for (int kt = 0; kt < 8; ++kt) acc[kt] = MFMA32(*(const GAS bf16x8*)(Kp + (size_t)kt * 32 * D + 16 * s2), bq, acc[kt]);
        asm volatile("" ::: "memory");
    }
    float mx = -1e30f;
#pragma unroll
    for (int kt = 0; kt < 8; ++kt)
#pragma unroll
        for (int i = 0; i < 16; ++i) mx = fmaxf(mx, acc[kt][i]);
    mx = fmaxf(mx, __shfl_xor(mx, 32));
    float l = 0.f;
#pragma unroll
    for (int kt = 0; kt < 8; ++kt)
#pragma unroll
        for (int i = 0; i < 16; ++i) { const float pv = __expf(acc[kt][i] - mx); acc[kt][i] = pv; l += pv; }
    l += __shfl_xor(l, 32);
    const float il = 1.f / l;
    bf16x8 Pb[8][2];
#pragma unroll
    for (int kt = 0; kt < 8; ++kt) { Pb[kt][0] = pack_step(acc[kt], 0); Pb[kt][1] = pack_step(acc[kt], 1); }
    bf16* ctx = (bf16*)(ws + WS_CTX) + (row0 + r) * D + head * 256 + 4 * hh;
#pragma unroll
    for (int dt = 0; dt < 8; ++dt) {
        f32x16 o;
#pragma unroll
        for (int i = 0; i < 16; ++i) o[i] = 0.f;
#pragma unroll
        for (int kt = 0; kt < 8; ++kt) {
#pragma unroll
            for (int s2 = 0; s2 < 2; ++s2) o = MFMA32(*(const GAS bf16x8*)(Vp + (size_t)dt * 32 * MMEM + 32 * kt + 16 * s2), Pb[kt][s2], o);
            if ((kt & 3) == 3) asm volatile("" ::: "memory"); }
#pragma unroll
        for (int g4 = 0; g4 < 4; ++g4) *(GAS v2u*)(ctx + 32 * dt + 8 * g4) = (v2u){pk2(o[4 * g4] * il, o[4 * g4 + 1] * il), pk2(o[4 * g4 + 2] * il, o[4 * g4 + 3] * il)};
        asm volatile("" ::: "memory");
    }
}
__device__ __forceinline__ void attn_sample_pass(Frame& F, int bp) {
    unsigned char* ws = F.ws; const int lane = F.lane, r = lane & 31, hh = lane >> 5;
    const int ul = F.wave >> 2, ds = F.wave & 3, unit = 2 * bp + ul, sb = unit >> 2, head = unit & 3;
    const float* Kc = F.in[I_CK] + (((size_t)sb * NMEM + r) * XH + head) * XD + 64 * ds + 8 * hh;
    const float* Vc = F.in[I_CV] + (((size_t)sb * NMEM) * XH + head) * XD + 64 * ds + r;
    const bf16* Q = (const bf16*)(ws + WS_Q) + ((size_t)MP + (size_t)sb * DS + (r & 7)) * D + head * 256 + 64 * ds + 8 * hh;
    f32x16 acc[8];
#pragma unroll
    for (int kt = 0; kt < 8; ++kt)
#pragma unroll
        for (int i = 0; i < 16; ++i) acc[kt][i] = 0.f;
#pragma unroll
    for (int s2 = 0; s2 < 4; ++s2) {
        bf16x8 bq = *(const GAS bf16x8*)(Q + 16 * s2);
        if (r >= 8) bq = (bf16x8){0, 0, 0, 0, 0, 0, 0, 0};
#pragma unroll
        for (int kt = 0; kt < 8; ++kt) { const float* kp = Kc + (size_t)kt * 32 * XH * XD + 16 * s2; asm volatile("" : "+v"(kp));
            const f32x4 k0 = *(const GAS f32x4*)kp, k1 = *(const GAS f32x4*)(kp + 4);
            const v4u ka = {pk2(k0[0], k0[1]), pk2(k0[2], k0[3]), pk2(k1[0], k1[1]), pk2(k1[2], k1[3])};
            acc[kt] = MFMA32(__builtin_bit_cast(bf16x8, ka), bq, acc[kt]);
            if (kt & 1) asm volatile("" ::: "memory"); }
    }
    LAS float* part = (LAS float*)(F.lds + ul * 32768);
    if (r < 8) {
#pragma unroll
        for (int kt = 0; kt < 8; ++kt)
#pragma unroll
            for (int i = 0; i < 16; ++i) part[(ds * 256 + 32 * kt + crow(i, hh)) * 8 + r] = acc[kt][i];
    }
    __syncthreads();
#pragma unroll
    for (int kt = 0; kt < 8; ++kt)
#pragma unroll
        for (int i = 0; i < 16; ++i) { float sv = 0.f;
            if (r < 8) { const int o = (32 * kt + crow(i, hh)) * 8 + r; sv = (part[o] + part[2048 + o]) + (part[4096 + o] + part[6144 + o]); }
            acc[kt][i] = sv; }
    float mx = -1e30f;
#pragma unroll
    for (int kt = 0; kt < 8; ++kt)
#pragma unroll
        for (int i = 0; i < 16; ++i) mx = fmaxf(mx, acc[kt][i]);
    mx = fmaxf(mx, __shfl_xor(mx, 32));
    float l = 0.f;
#pragma unroll
    for (int kt = 0; kt < 8; ++kt)
#pragma unroll
        for (int i = 0; i < 16; ++i) { const float pv = __expf(acc[kt][i] - mx); acc[kt][i] = pv; l += pv; }
    l += __shfl_xor(l, 32);
    const float il = 1.f / l;
    bf16x8 Pb[8][2];
#pragma unroll
    for (int kt = 0; kt < 8; ++kt) { Pb[kt][0] = pack_step(acc[kt], 0); Pb[kt][1] = pack_step(acc[kt], 1); }
    bf16* ctx = (bf16*)(ws + WS_CTX) + ((size_t)MP + (size_t)sb * DS + (r & 7)) * D + head * 256 + 64 * ds + 4 * hh;
#pragma unroll
    for (int dt = 0; dt < 2; ++dt) {
        f32x16 o;
#pragma unroll
        for (int i = 0; i < 16; ++i) o[i] = 0.f;
#pragma unroll
        for (int kt = 0; kt < 8; ++kt) {
#pragma unroll
            for (int s2 = 0; s2 < 2; ++s2) { float vv[8]; const float* vk = Vc + (size_t)(32 * kt + 16 * s2 + 4 * hh) * XH * XD + 32 * dt; asm volatile("" : "+v"(vk));
#pragma unroll
                for (int j = 0; j < 8; ++j) vv[j] = vk[(size_t)(8 * (j >> 2) + (j & 3)) * XH * XD];
                const v4u va = {pk2(vv[0], vv[1]), pk2(vv[2], vv[3]), pk2(vv[4], vv[5]), pk2(vv[6], vv[7])};
                o = MFMA32(__builtin_bit_cast(bf16x8, va), Pb[kt][s2], o); }
            asm volatile("" ::: "memory"); }
        if (r < 8) {
#pragma unroll
            for (int g4 = 0; g4 < 4; ++g4) *(GAS v2u*)(ctx + 32 * dt + 8 * g4) = (v2u){pk2(o[4 * g4] * il, o[4 * g4 + 1] * il), pk2(o[4 * g4 + 2] * il, o[4 * g4 + 3] * il)};
        }
    }
    __syncthreads();
}
__device__ __forceinline__ void final_norm_pass(Frame& F) {
    const float* ssq = (const float*)(F.ws + WS_SSQ) + 2 * (size_t)M * 16; float* y = F.out + O_Y;
    const int gw = F.vcu * NWAVES + F.wave, NGW = F.G * NWAVES;
    f32x4 gw4[4];
#pragma unroll
    for (int j = 0; j < 4; ++j) gw4[j] = *(const GAS f32x4*)(F.in[I_NF] + 4 * F.lane + 256 * j);
    for (int m = gw; m < M; m += NGW) { const float rs = row_rs(ssq, m); GAS f32x4* yr = (GAS f32x4*)(y + (size_t)m * D) + F.lane;
#pragma unroll
        for (int j = 0; j < 4; ++j) yr[64 * j] = yr[64 * j] * rs * gw4[j]; }
}

__device__ __forceinline__ void copy_conv_states(Frame& F) {
    const bf16* qkv = (const bf16*)(F.ws + WS_QKV); const bf16* upre = (const bf16*)(F.ws + WS_UPRE);
    const int gt = F.vcu * (NWAVES * 64) + F.tid, NT = F.G * NWAVES * 64;
    const int n1 = (NB + DB) * 3 * 3072;
    for (int e = gt; e < n1; e += NT) { const int c = e % 3072, r = (e / 3072) % 3, s = e / (3 * 3072);
        const size_t row = (s < NB) ? (size_t)s * SEQ + (SEQ - 3 + r) : (size_t)MP + (size_t)(s - NB) * DS + (DS - 3 + r);
        const float v = bf2f(qkv[row * 3072 + c]);
        if (s < NB) F.out[O_GCP + ((size_t)s * 3 + r) * 3072 + c] = v; else F.out[O_GCS + ((size_t)(s - NB) * 3 + r) * 3072 + c] = v; }
    const int n2 = (NB + DB) * 2 * D;
    for (int e = gt; e < n2; e += NT) { const int c = e % D, r = (e / D) % 2, s = e / (2 * D);
        const size_t row = (s < NB) ? (size_t)s * SEQ + (SEQ - 2 + r) : (size_t)MP + (size_t)(s - NB) * DS + (DS - 2 + r);
        const float v = bf2f(upre[row * D + c]);
        if (s < NB) F.out[O_SCP + ((size_t)s * 2 + r) * D + c] = v; else F.out[O_SCS + ((size_t)(s - NB) * 2 + r) * D + c] = v; }
}


#ifndef MK_DEBUG
#define MK_DEBUG 0
#endif
#if MK_DEBUG
constexpr int CW_CHK = 512;
__device__ __forceinline__ unsigned hash_u(unsigned x) { x ^= x >> 16; x *= 0x7feb352du; x ^= x >> 15; x *= 0x846ca68bu; x ^= x >> 16; return x; }
__device__ __forceinline__ void chk_put(Frame& F, int ch, float got, float ref, float floor_) {
    float e = (got - ref) * (got - ref); if (!(e == e) || e > 1e30f) e = 1e30f;
    atomicAdd((float*)(F.ctl + CW_CHK + 2 * ch), e); atomicAdd((float*)(F.ctl + CW_CHK + 2 * ch + 1), ref * ref);
}
__device__ __forceinline__ float bfround(float x) { return bflo(pk2(x, 0.f) & 0xffffu); }
#if 0
__device__ __forceinline__ void debug_checks(Frame& F) {
    const unsigned gt = (unsigned)(F.vcu * (NWAVES * 64) + F.tid);
    unsigned char* ws = F.ws;
    const bf16* win = (const bf16*)(ws + WS_WIN); const bf16* xn = (const bf16*)(ws + WS_XN); const bf16* mn = (const bf16*)(ws + WS_MN);
    const bf16* wxkv = (const bf16*)(ws + WS_WXKV);
    { const unsigned h = hash_u(gt * 3u + 1u); const int n = h % NIN_T, k = (h >> 16) % D;
      chk_put(F, 0, bf2f(win[(size_t)n * D + k]), bfround(F.in[I_WIN][(size_t)k * NIN + win_src_col(n)]), 1e-6f);
      const int n2 = h % 2048; chk_put(F, 0, bf2f(wxkv[(size_t)n2 * D + k]), bfround(F.in[I_WXKV][(size_t)k * 2048 + n2]), 1e-6f);
      const int n3 = h % 1024, k3 = (h >> 12) % FF; chk_put(F, 0, bf2f(((const bf16*)(ws + WS_WDN))[(size_t)n3 * FF + k3]), bfround(F.in[I_WDN][(size_t)k3 * D + n3]), 1e-6f);
      const int n4 = h % FF; chk_put(F, 0, bf2f(((const bf16*)(ws + WS_WUP))[(size_t)n4 * D + k]), bfround(F.in[I_WUP][(size_t)k * FF + n4]), 1e-6f);
      chk_put(F, 0, bf2f(((const bf16*)(ws + WS_WXO))[(size_t)n3 * D + k]), bfround(F.in[I_WXO][(size_t)k * D + n3]), 1e-6f);
      chk_put(F, 0, bf2f(((const bf16*)(ws + WS_WGDNO))[(size_t)n3 * D + k]), bfround(F.in[I_WGDNO][(size_t)k * D + n3]), 1e-6f); }
    if (gt < 4096) { const unsigned h = hash_u(gt * 7u + 5u); const int m = h % M; const float* xr = (m < MP) ? F.in[I_XP] + (size_t)m * D : F.in[I_XS] + (size_t)(m - MP) * D;
      float s = 0.f; for (int k = 0; k < D; ++k) s += xr[k] * xr[k]; const float rs = 1.f / sqrtf(s / D + EPS); const int k0 = (h >> 16) % D;
      chk_put(F, 1, bf2f(xn[(size_t)m * D + k0]), xr[k0] * rs * F.in[I_NMIX][k0], 1e-3f);
      const int o = (h >> 8) & 15; float a = 0.f; for (int k = 0; k < D; ++k) a += xr[k] * rs * F.in[I_NMIX][k] * F.in[I_WIN][(size_t)k * NIN + 4096 + o];
      chk_put(F, 2, ((const float*)(ws + WS_AB))[(size_t)m * 16 + o], a, 1e-2f);
      const int mm = h % MMEM; const float* mr = F.in[I_MEM] + (size_t)mm * D; s = 0.f; for (int k = 0; k < D; ++k) s += mr[k] * mr[k]; const float rs2 = 1.f / sqrtf(s / D + EPS);
      chk_put(F, 1, bf2f(mn[(size_t)mm * D + k0]), mr[k0] * rs2 * F.in[I_NMEM][k0], 1e-3f); }
    if (gt < 16384) { const unsigned h = hash_u(gt * 11u + 3u); const int m = h % M, n = (h >> 9) % NIN_T;
      float d = 0.f; for (int k = 0; k < D; ++k) d += bf2f(xn[(size_t)m * D + k]) * bf2f(win[(size_t)n * D + k]);
      const int pn = n >> 8, c = n & 255;
      if (pn < 12) chk_put(F, 3, bf2f(((const bf16*)(ws + WS_QKV))[(size_t)m * 3072 + n]), d, 2e-2f);
      else if (pn < 16) chk_put(F, 4, bf2f(((const bf16*)(F.out + O_Y))[(size_t)m * D + (n - 3072)]), d / (1.f + expf(-d)), 2e-2f);
      else if (pn < 20) chk_put(F, 4, bf2f((((const bf16*)(F.out + O_Y)) + (size_t)M * D)[(size_t)m * D + (n - 4096)]), d, 2e-2f);
      else if (pn < 28) { const int n2 = (c < 128) ? n + 128 : n - 128; float d2 = 0.f; for (int k = 0; k < D; ++k) d2 += bf2f(xn[(size_t)m * D + k]) * bf2f(win[(size_t)n2 * D + k]);
          chk_put(F, 5, bf2f(((const bf16*)(ws + WS_UPRE))[(size_t)m * D + 128 * (pn - 20) + (c & 127)]), d * d2, 2e-2f); }
      else if (pn < 32) chk_put(F, 4, bf2f(((const bf16*)(ws + WS_SGA))[(size_t)m * D + (n - 7168)]), 1.f / (1.f + expf(-d)), 2e-2f);
      else chk_put(F, 4, bf2f(((const bf16*)(ws + WS_SGB))[(size_t)m * D + (n - 8192)]), 1.f / (1.f + expf(-d)), 2e-2f);
      const int mm = h % MMEM, nn = (h >> 11) % 2048; float dk = 0.f; for (int k = 0; k < D; ++k) dk += bf2f(mn[(size_t)mm * D + k]) * bf2f(wxkv[(size_t)nn * D + k]);
      if (nn < 1024) { chk_put(F, 6, F.out[O_MK + (size_t)mm * D + nn], dk, 2e-2f); chk_put(F, 6, bf2f(((const bf16*)(ws + WS_KB))[(size_t)mm * D + nn]), dk, 2e-2f); }
      else { chk_put(F, 6, F.out[O_MV + (size_t)mm * D + (nn - 1024)], dk, 2e-2f);
          const int key = mm & 255, kp = (key & ~12) | ((key & 4) << 1) | ((key & 8) >> 1);
          chk_put(F, 7, bf2f(((const bf16*)(ws + WS_VT))[(size_t)(nn - 1024) * MMEM + (mm & ~255) + kp]), dk, 2e-2f); } }
}

#endif
__device__ __forceinline__ void debug_checks(Frame& F) {
    const unsigned gt = (unsigned)(F.vcu * (NWAVES * 64) + F.tid);
    unsigned char* ws = F.ws;
    if (gt < 512) { const int idx = gt >> 3, hd = gt & 7; const int m = hash_u(idx * 29u + 11u) % M; const bf16* og = (const bf16*)(ws + WS_O); const bf16* sz = (const bf16*)(F.out + O_Y);
        const bf16* osv = (const bf16*)(ws + WS_END - 2 * MiB) + (size_t)idx * D + hd * 128;
        float ss = 0.f; for (int dv = 0; dv < 128; ++dv) { const float o = bf2f(osv[dv]); ss += o * o; } const float rs = 1.f / sqrtf(ss / 128.f + EPS);
        for (int dv = 0; dv < 128; ++dv) chk_put(F, 1, bf2f(og[(size_t)m * D + hd * 128 + dv]), bf2f(osv[dv]) * rs * F.in[I_GON][dv] * bf2f(sz[(size_t)m * D + hd * 128 + dv]), 0.f); }
    if (gt < 16384) { const unsigned h = hash_u(gt * 11u + 3u); const int m = h % M, c = (h >> 15) % D; const bf16* xn0 = nullptr; (void)xn0;
        const bf16* upre = (const bf16*)(ws + WS_UPRE); const bf16* ub = (const bf16*)(F.out + O_Y) + (size_t)M * D;
        const bool smp = m >= MP; const int t = smp ? ((m - MP) & 7) : (m & (SEQ - 1)); const int sb = smp ? ((m - MP) >> 3) : 0;
        float conv = 0.f; for (int k = 0; k < 3; ++k) { const int tt = t - 2 + k; float xv = 0.f; if (tt >= 0) xv = bf2f(upre[(size_t)(m - 2 + k) * D + c]); else if (smp) xv = F.in[I_SSC][((size_t)sb * 2 + (2 + tt)) * D + c]; conv += F.in[I_SCW][(size_t)k * D + c] * xv; }
        const float* xr = (m < MP) ? F.in[I_XP] + (size_t)m * D : F.in[I_XS] + (size_t)(m - MP) * D; float ss = 0.f; for (int k = 0; k < D; ++k) ss += xr[k] * xr[k]; const float rs = 1.f / sqrtf(ss / D + EPS);
        float bgv = 0.f; for (int k = 0; k < D; ++k) bgv += xr[k] * rs * F.in[I_NMIX][k] * F.in[I_WIN][(size_t)k * NIN + 4112 + c];
        chk_put(F, 2, bf2f(ub[(size_t)m * D + c]), bgv * conv, 3e-2f); }
}
__device__ __forceinline__ void naive_gdn_col(Frame& F, size_t rowb, int T, const float* hist, const float* S0  , int h, int dv, float* Scol  , int ch, bool check_o) {
    const bf16* qkv = (const bf16*)(F.ws + WS_QKV); const float* gcw = F.in[I_GCW]; const bf16* Og = (const bf16*)(F.ws + WS_O);
    for (int dk = 0; dk < 128; ++dk) Scol[dk] = S0 ? S0[(size_t)dk * 128 + dv] : 0.f;
    const float eA = expf(F.in[I_ALOG][h]), dtb = F.in[I_DTB][h];
    for (int t = 0; t < T; ++t) {
        float ssk = 0.f, ssq = 0.f, kS = 0.f;
        for (int pass = 0; pass < 2; ++pass) {
            float o = 0.f, rk = 0.f, rq = 0.f, uu = 0.f, eg = 0.f;
            if (pass == 1) {
                rk = 1.f / sqrtf(ssk + 1e-6f); rq = 1.f / sqrtf(ssq + 1e-6f) * 0.08838834764831845f;
                const float* ab = (const float*)(F.ws + WS_AB) + (rowb + t) * 16;
                const float g = -eA * log1pf(expf(ab[h] + dtb)); eg = expf(g); const float beta = 1.f / (1.f + expf(-ab[8 + h]));
                float vv = 0.f; { const int col = 2048 + h * 128 + dv; for (int i = 0; i < 4; ++i) { const int tt = t - 3 + i; const float xv = (tt >= 0) ? bf2f(qkv[(rowb + tt) * 3072 + col]) : (hist ? hist[(size_t)(3 + tt) * 3072 + col] : 0.f); vv += gcw[(size_t)i * 3072 + col] * xv; } vv = vv / (1.f + expf(-vv)); }
                uu = beta * (vv - eg * kS * rk);
            }
            for (int dk = 0; dk < 128; ++dk) {
                float kv = 0.f, qv = 0.f;
                for (int i = 0; i < 4; ++i) { const int tt = t - 3 + i; const int ck = 1024 + h * 128 + dk, cq = h * 128 + dk;
                    const float xk = (tt >= 0) ? bf2f(qkv[(rowb + tt) * 3072 + ck]) : (hist ? hist[(size_t)(3 + tt) * 3072 + ck] : 0.f);
                    const float xq = (tt >= 0) ? bf2f(qkv[(rowb + tt) * 3072 + cq]) : (hist ? hist[(size_t)(3 + tt) * 3072 + cq] : 0.f);
                    kv += gcw[(size_t)i * 3072 + ck] * xk; qv += gcw[(size_t)i * 3072 + cq] * xq; }
                kv = kv / (1.f + expf(-kv)); qv = qv / (1.f + expf(-qv));
                if (pass == 0) { ssk += kv * kv; ssq += qv * qv; kS += Scol[dk] * kv; }
                else { Scol[dk] = eg * Scol[dk] + kv * rk * uu; o += Scol[dk] * qv * rq; }
            }
            if (pass == 1 && check_o && (t % 61 == 0 || t == T - 1)) chk_put(F, ch - 5, bf2f(Og[(rowb + t) * D + h * 128 + dv]), o, 2e-2f);
        }
    }
}
__device__ __forceinline__ void debug_checks_gdn(Frame& F) {
    float* scr = (float*)(F.ws + WS_END - 4 * MiB);
    const unsigned gt = (unsigned)(F.vcu * (NWAVES * 64) + F.tid);
    if (gt < 64) {
        const unsigned hsh = hash_u(gt * 13u + 7u); const int b = hsh % DB, h = (hsh >> 8) & 7, dv = (hsh >> 12) & 127;
        float* Scol = scr + (size_t)gt * 128;
        naive_gdn_col(F, (size_t)MP + (size_t)b * DS, DS, F.in[I_SGC] + (size_t)b * 3 * 3072, F.in[I_SG] + (size_t)(b * 8 + h) * 128 * 128, h, dv, Scol, 8, true);
        for (int dk = 0; dk < 128; ++dk) chk_put(F, 8, F.out[O_GSS + ((size_t)(b * 8 + h) * 128 + dk) * 128 + dv], Scol[dk], 1e-3f);
    } else if (gt >= 1024 && gt < 1024 + 64) {
        const int idx = gt - 1024; const int m = hash_u(idx * 29u + 11u) % M; const bf16* Og = (const bf16*)(F.ws + WS_O); bf16* osv = (bf16*)(F.ws + WS_END - 2 * MiB) + (size_t)idx * D;
        for (int k = 0; k < D; ++k) osv[k] = Og[(size_t)m * D + k];
    } else if (gt >= 512 && gt < 512 + 32) {
        const unsigned hsh = hash_u(gt * 17u + 3u); const int b = hsh % NB, h = (hsh >> 8) & 7, dv = (hsh >> 12) & 127;
        float* Scol = scr + (size_t)(gt - 512 + 64) * 128;
        naive_gdn_col(F, (size_t)b * SEQ, SEQ, nullptr, nullptr, h, dv, Scol, 9, true);
        for (int dk = 0; dk < 128; ++dk) chk_put(F, 9, F.out[O_GSP + ((size_t)(b * 8 + h) * 128 + dk) * 128 + dv], Scol[dk], 1e-3f);
    }
}
__device__ __forceinline__ void debug_report(Frame& F) {
    const size_t osz[10] = {(size_t)MP * D, (size_t)MS * D, (size_t)MMEM * D, (size_t)MMEM * D, (size_t)NB * 3 * 3072, (size_t)NB * NH * DK * DK, (size_t)NB * 2 * D, (size_t)DB * 3 * 3072, (size_t)DB * NH * DK * DK, (size_t)DB * 2 * D};
    const size_t gt = (size_t)F.vcu * (NWAVES * 64) + F.tid, NT = (size_t)F.G * NWAVES * 64; size_t off = 0;
    for (int c = 0; c < 10; ++c) {
        const float num = __uint_as_float(__hip_atomic_load(F.ctl + CW_CHK + 2 * c, RLX_AGENT)), den = __uint_as_float(__hip_atomic_load(F.ctl + CW_CHK + 2 * c + 1, RLX_AGENT));
        int cnt = (den <= 0.f) ? 99 : (num <= 0.f) ? 98 : (int)(10.f - 10.f * log10f(num / den) + 0.5f); cnt = cnt < 10 ? 10 : (cnt > 97 ? 97 : cnt);
        for (size_t i = gt; i < osz[c]; i += NT) F.out[off + i] = (i < (size_t)cnt) ? __uint_as_float(0xAAAAAAAAu) : 1.0f;
        off += osz[c];
    }
}
#endif

constexpr int PH_P2C = 4 + MK_DEBUG, PH_P3 = PH_P2C + 1, PH_P4 = PH_P3 + 1, PH_P5 = PH_P4 + 1, PH_P6 = PH_P5 + 1, PH_P7 = PH_P6 + 1, PH_P8 = PH_P7 + 1, PH_P9 = PH_P8 + 1, PH_P10 = PH_P9 + 1, PH_LAST = PH_P10;
constexpr int N_PHASES = PH_LAST + 1 + 2 * MK_DEBUG;
__global__ void __launch_bounds__(NWAVES * 64, 2) mk_fwd(Args args) {
    extern __shared__ __attribute__((aligned(16))) unsigned char lds[];
    Frame F;
    F.lds = (LAS unsigned char*)lds;
    F.MISC = (volatile LAS unsigned*)(F.lds + MISC_OFF);
    F.tid = threadIdx.x; F.lane = F.tid & 63; F.wave = __builtin_amdgcn_readfirstlane(F.tid >> 6);
    F.G = gridDim.x; { const int bx = blockIdx.x; F.vcu = (F.G % 8 == 0) ? (bx % 8) * (F.G / 8) + bx / 8 : bx; }
    F.in = args.in; F.out = args.out; F.ws = args.ws;
    F.ctl = (gu32*)(args.ws + WS_CTL);
    for (int u = F.tid; u < (LDS_BYTES - LDSCTL_OFF) / 4; u += NWAVES * 64) ((LAS unsigned*)(F.lds + LDSCTL_OFF))[u] = 0u;
    __syncthreads();
    XcdBarrier bar = xcd_barrier_post((unsigned*)(F.ctl + CW_BAR) + args.li * XCD_BAR_WORDS, F.MISC + 8);
    const int lo = args.ph_lo, hi = args.ph_hi;
#define IN(k) (lo <= (k) && (k) < hi)
#define BOTH(k) (IN(k) && IN((k) + 1))
#define GRID_BAR() xcd_barrier(bar)
    unsigned char* ws = args.ws;

    if (IN(0)) { p0_prologue(F); if (BOTH(0)) GRID_BAR(); }

    if (IN(1)) {
        LAS unsigned* tab = (LAS unsigned*)(F.lds + TAB_OFF);
        if (F.tid == 0) {
            tab[0] = (unsigned)WS_XN; tab[4] = (unsigned)WS_WIN; tab[8] = M / 256; tab[12] = NIN_T / 256;
            tab[1] = (unsigned)WS_MN; tab[5] = (unsigned)WS_WXKV; tab[9] = MMEM / 256; tab[13] = 8;
            tab[2] = (unsigned)(WS_WXKV + (size_t)D * D * 2); tab[6] = (unsigned)WS_MN; tab[10] = D / 256; tab[14] = MMEM / 256; }
        __syncthreads();
        pg8::Probs P{ws, tab, 3, D};
        pg8::GroupOrder S; S.init(P, F.G, (int)blockIdx.x);
        EpiP1 E{ws, F.out};
        pg8::gemm_phase<EpiP1, pg8::GroupOrder>(F.lds + RING_OFF, P, S, E);
        if (BOTH(1)) GRID_BAR();
    }

    if (IN(2)) {
        for (int u = F.vcu; u < NB * NH * 32; u += F.G) gdn_prep_unit(F, u);
        for (int su = F.vcu; su < DB * NH / 4; su += F.G) gdn_sample_unit(F, su);
        sc_conv_pass(F);
        copy_conv_states(F);
        if (BOTH(2)) GRID_BAR();
    }
    if (IN(3)) {
        for (int bh = F.vcu; bh < NB * NH; bh += F.G) if (F.wave < 4) gdn_scan_wave(F, bh, F.wave);
        if (BOTH(3)) GRID_BAR();
    }
#if MK_DEBUG
    if (IN(4)) { debug_checks_gdn(F); }
#endif
    if (IN(PH_P2C)) { og_pass(F); if (BOTH(PH_P2C)) GRID_BAR(); }
    LAS unsigned* tab = (LAS unsigned*)(F.lds + TAB_OFF);
    float* const ssq = (float*)(ws + WS_SSQ);
#define SET_TAB1(oa, ob, nm, nn) do { __syncthreads(); if (F.tid == 0) { tab[0] = (unsigned)(oa); tab[4] = (unsigned)(ob); tab[8] = (nm); tab[12] = (nn); } __syncthreads(); } while (0)
    if (IN(PH_P3)) {
        __syncthreads();
        if (F.tid == 0) { tab[0] = (unsigned)((size_t)((unsigned char*)(F.out + O_Y) - ws) + (size_t)M * D * 2); tab[4] = (unsigned)WS_WSCO; tab[8] = M / 256; tab[12] = 4; tab[1] = (unsigned)WS_O; tab[5] = (unsigned)WS_WGDNO; tab[9] = M / 256; tab[13] = 4; }
        __syncthreads();
        pg8::Probs P{ws, tab, 2, D}; pg8::PairOrder S; S.init(P, F.G, (int)blockIdx.x);
        EpiP3 E{ws};
        pg8::gemm_phase<EpiP3, pg8::PairOrder>(F.lds + RING_OFF, P, S, E);
        if (BOTH(PH_P3)) GRID_BAR();
    }
    if (IN(PH_P4)) {
        SET_TAB1(WS_MG, WS_WMIX, M / 256, 4);
        pg8::Probs P{ws, tab, 1, D}; pg8::GroupOrder S; S.init(P, F.G, (int)blockIdx.x);
        EpiRes<true> E{F.in[I_XP], F.in[I_XS], F.out + O_Y, F.in[I_NX], (bf16*)(ws + WS_XN), ssq, true};
        pg8::gemm_phase<EpiRes<true>, pg8::GroupOrder>(F.lds + RING_OFF, P, S, E);
        if (BOTH(PH_P4)) GRID_BAR();
    }
    if (IN(PH_P5)) {
        SET_TAB1(WS_XN, WS_WXQ, M / 256, 4);
        pg8::Probs P{ws, tab, 1, D}; pg8::GroupOrder S; S.init(P, F.G, (int)blockIdx.x);
        EpiScale<0> E{ssq, (bf16*)(ws + WS_Q), D, 0.0625f};
        pg8::gemm_phase<EpiScale<0>, pg8::GroupOrder>(F.lds + RING_OFF, P, S, E);
        if (BOTH(PH_P5)) GRID_BAR();
    }
    if (IN(PH_P6)) {
        for (int u = F.vcu; u < NB * XH * 8; u += F.G) attn_prompt_unit(F, u);
        for (int bp = F.vcu; bp < DB * XH / 2; bp += F.G) attn_sample_pass(F, bp);
        if (BOTH(PH_P6)) GRID_BAR();
    }
    if (IN(PH_P7)) {
        SET_TAB1(WS_CTX, WS_WXO, M / 256, 4);
        pg8::Probs P{ws, tab, 1, D}; pg8::GroupOrder S; S.init(P, F.G, (int)blockIdx.x);
        EpiRes<false> E{nullptr, nullptr, F.out + O_Y, F.in[I_NMLP], (bf16*)(ws + WS_XN), ssq + (size_t)M * 16, true};
        pg8::gemm_phase<EpiRes<false>, pg8::GroupOrder>(F.lds + RING_OFF, P, S, E);
        if (BOTH(PH_P7)) GRID_BAR();
    }
    if (IN(PH_P8)) {
        SET_TAB1(WS_XN, WS_WUP, M / 256, FF / 256);
        pg8::Probs P{ws, tab, 1, D}; pg8::GroupOrder S; S.init(P, F.G, (int)blockIdx.x);
        EpiScale<1> E{ssq + (size_t)M * 16, (bf16*)(ws + WS_HB), FF, 1.f};
        pg8::gemm_phase<EpiScale<1>, pg8::GroupOrder>(F.lds + RING_OFF, P, S, E);
        if (BOTH(PH_P8)) GRID_BAR();
    }
    if (IN(PH_P9)) {
        SET_TAB1(WS_HB, WS_WDN, M / 256, 4);
        pg8::Probs P{ws, tab, 1, FF}; pg8::GroupOrder S; S.init(P, F.G, (int)blockIdx.x);
        EpiRes<false> E{nullptr, nullptr, F.out + O_Y, F.in[I_NF], nullptr, ssq + 2 * (size_t)M * 16, false};
        pg8::gemm_phase<EpiRes<false>, pg8::GroupOrder>(F.lds + RING_OFF, P, S, E);
        if (BOTH(PH_P9)) GRID_BAR();
    }
    if (IN(PH_P10)) { final_norm_pass(F); }
#if MK_DEBUG
    if (IN(N_PHASES - 2)) { debug_checks(F); if (BOTH(N_PHASES - 2)) GRID_BAR(); }
    if (IN(N_PHASES - 1)) { debug_report(F); }
#endif
#undef IN
#undef BOTH
}

#ifndef MK_ONE_LAUNCH
#define MK_ONE_LAUNCH 1
#endif
extern "C" void kernel_launch(void* const* d_in, const int* in_sizes, int n_in, void* d_out, int out_size, void* d_ws, size_t ws_size, hipStream_t stream) {
    static int grid = 0;
    if (grid == 0) {
        if (n_in != 27 || out_size != (int)O_END || ws_size < WS_END) { fprintf(stderr, "kernel_launch: unexpected shapes: n_in %d out %d ws %zu (need %zu)\n", n_in, out_size, ws_size, (size_t)WS_END); grid = -1; return; }
        int dev = 0, cus = 0;
        if (hipGetDevice(&dev) != hipSuccess || hipDeviceGetAttribute(&cus, hipDeviceAttributeMultiprocessorCount, dev) != hipSuccess) { grid = -1; return; }
        if (hipFuncSetAttribute((const void*)mk_fwd, hipFuncAttributeMaxDynamicSharedMemorySize, LDS_BYTES) != hipSuccess) { fprintf(stderr, "kernel_launch: hipFuncSetAttribute failed\n"); grid = -1; return; }
        int per_cu = 0;
        (void)hipOccupancyMaxActiveBlocksPerMultiprocessor(&per_cu, (const void*)mk_fwd, NWAVES * 64, LDS_BYTES);
        (void)hipGetLastError();
        grid = cus;
    }
    if (grid < 0) return;
    (void)hipMemsetAsync((char*)d_ws + WS_CTL, 0, CTL_ZERO_BYTES, stream);
    Args a{};
    for (int i = 0; i < 27; ++i) a.in[i] = (const float*)d_in[i];
    a.out = (float*)d_out; a.ws = (unsigned char*)d_ws;
#if MK_ONE_LAUNCH
    a.ph_lo = 0; a.ph_hi = N_PHASES; a.li = 0;
    hipLaunchKernelGGL(mk_fwd, dim3(grid), dim3(NWAVES * 64), LDS_BYTES, stream, a);
#else
    for (int p = 0; p < N_PHASES; ++p) { a.ph_lo = p; a.ph_hi = p + 1; a.li = p;
        hipLaunchKernelGGL(mk_fwd, dim3(grid), dim3(NWAVES * 64), LDS_BYTES, stream, a); }
#endif
}
```

```cpp
#include <hip/hip_runtime.h>
#include <cstdio>
#include <cstdint>
#include <cmath>
#ifndef MK_DEBUG
#define MK_DEBUG 0
#endif
#ifndef MK_TIMING
#define MK_TIMING 0
#endif
#ifndef MK_EXP
#define MK_EXP 0
#endif

namespace pg8 {
#define PG8_LAS __attribute__((address_space(3)))
typedef unsigned short bf16_t;
typedef short bf16x8 __attribute__((ext_vector_type(8)));
typedef float f32x4 __attribute__((ext_vector_type(4)));
typedef unsigned u32x4 __attribute__((ext_vector_type(4)));
typedef unsigned u32x2 __attribute__((ext_vector_type(2)));
constexpr int BM = 256, BK = 64, HALF = 128, HTB = HALF * BK * 2, STAGE_BYTES = 8 * HTB, NXCD = 8, WGM = 8;

__host__ __device__ __forceinline__ int lds_byte(int r, int c) { const int st = (r >> 4) * 2 + (c >> 5), rr = r & 15, cc = c & 31, ob = rr * 64 + cc * 2; return st * 1024 + (ob ^ (((ob >> 9) & 1) << 5)); }
__host__ __device__ __forceinline__ void stage_rc(int b, int& R, int& C) { const int st = b / 1024, sb = b % 1024, swz = sb ^ (((sb >> 9) & 1) << 5); R = (st >> 1) * 16 + swz / 64; C = (st & 1) * 32 + (swz % 64) / 2; }
__host__ __device__ __forceinline__ int perm32(int rho) { const int n = rho >> 4, i = rho & 15; return 8 * (i >> 2) + 4 * n + (i & 3); }

struct Unit { int pm, pn, g; };
constexpr int MAXG = 4;
struct Probs { const unsigned char* base; PG8_LAS const unsigned* tab; int ng; int K; };
__device__ __forceinline__ int tabv(PG8_LAS const unsigned* tab, int i) { return __builtin_amdgcn_readfirstlane((int)tab[i]); }

struct GroupOrder {
    PG8_LAS const unsigned* tab; int ng, G, c;
    __device__ __forceinline__ void init(const Probs& P, int G_, int c_) { tab = P.tab; ng = P.ng; G = G_; c = c_; }
    __device__ __forceinline__ bool next(int i, Unit& u) const {
        int L = i * G + c; int g = -1, nm = 1, nn = 1, nwg = 1;
        for (int p = 0; p < ng; ++p) { const int a = tabv(tab, 8 + p), b = tabv(tab, 12 + p); if (L < a * b) { g = p; nm = a; nn = b; nwg = a * b; break; } L -= a * b; }
        if (g < 0) return false;
        int wgid = L; { const int q = nwg / NXCD, r = nwg % NXCD, xcd = wgid % NXCD, off = wgid / NXCD; wgid = (xcd < r ? xcd * (q + 1) : r * (q + 1) + (xcd - r) * q) + off; }
        const int nig = WGM * nn, gid = wgid / nig, fm = gid * WGM, gsz = (nm - fm) < WGM ? (nm - fm) : WGM;
        u.pm = fm + ((wgid % nig) % gsz); u.pn = (wgid % nig) / gsz; u.g = g; return true;
    }
};

__device__ __forceinline__ unsigned cvt_pk_bf16(float lo, float hi) { unsigned r; asm volatile("v_cvt_pk_bf16_f32 %0, %1, %2" : "=v"(r) : "v"(lo), "v"(hi)); return r; }

struct PairOrder {
    PG8_LAS const unsigned* tab; int ng, G, c;
    __device__ __forceinline__ void init(const Probs& P, int G_, int c_) { tab = P.tab; ng = P.ng; G = G_; c = c_; }
    __device__ __forceinline__ bool next(int i, Unit& u) const {
        const int nm = tabv(tab, 8), nn = tabv(tab, 12), nwg = nm * nn; const int L = (i >> 1) * G + c; if (L >= nwg) return false;
        int wgid = L; { const int q = nwg / NXCD, r = nwg % NXCD, xcd = wgid % NXCD, off = wgid / NXCD; wgid = (xcd < r ? xcd * (q + 1) : r * (q + 1) + (xcd - r) * q) + off; }
        const int nig = WGM * nn, gid = wgid / nig, fm = gid * WGM, gsz = (nm - fm) < WGM ? (nm - fm) : WGM;
        u.pm = fm + ((wgid % nig) % gsz); u.pn = (wgid % nig) / gsz; u.g = i & 1; return true;
    }
};

template <class Epi, class Sched>
__device__ __forceinline__ void gemm_phase(PG8_LAS unsigned char* lds, const Probs& P, const Sched& S, const Epi& E) {
    const int tid = threadIdx.x, wid = __builtin_amdgcn_readfirstlane(tid >> 6), lane = tid & 63, wr = wid >> 2, wc = wid & 3, fr = lane & 15, fq = lane >> 4;
    const int K = P.K, nt = K / BK;
    unsigned voffA[2], voffB[2];
#pragma unroll
    for (int i = 0; i < 2; ++i) { int R, C; stage_rc(tid * 16 + i * 8192, R, C); const int Rb = (R & ~31) + perm32(R & 31);
        voffA[i] = (unsigned)(R * K + C) * 2u; voffB[i] = (unsigned)(Rb * K + C) * 2u; }
    const size_t kstep = (size_t)(BK * 2);
    const size_t hstep = (size_t)HALF * K * 2;
    const size_t tstep = 2 * hstep;
    const unsigned ldsw = (unsigned)wid * 1024u;
    const int aoff = lds_byte(wr * 64 + fr, fq * 8), boff = lds_byte(wc * 32 + fr, fq * 8);
#define PG8_SA(b, h) (((b) * 2 + (h)) * HTB)
#define PG8_SB(b, h) ((4 + (b) * 2 + (h)) * HTB)
#define PG8_STAGE(bufoff, gbase, voff) do { _Pragma("unroll") for (int _i = 0; _i < 2; ++_i) \
        __builtin_amdgcn_global_load_lds((const unsigned*)((const char*)(gbase) + (voff)[_i]), (PG8_LAS unsigned*)(lds + (bufoff) + ldsw + _i * 8192), 16, 0, 0); } while (0)
#define PG8_LDA(dst, b, h) do { _Pragma("unroll") for (int m = 0; m < 4; ++m) _Pragma("unroll") for (int k = 0; k < 2; ++k) dst[m][k] = *(const PG8_LAS bf16x8*)(lds + PG8_SA(b, h) + aoff + m * 2048 + k * 1024); } while (0)
#define PG8_LDB(dst, b, h) do { _Pragma("unroll") for (int n = 0; n < 2; ++n) _Pragma("unroll") for (int k = 0; k < 2; ++k) dst[n][k] = *(const PG8_LAS bf16x8*)(lds + PG8_SB(b, h) + boff + n * 2048 + k * 1024); } while (0)
#define PG8_MMA(ai, bj, At, Bt) do { __builtin_amdgcn_s_setprio(1); _Pragma("unroll") for (int m = 0; m < 4; ++m) _Pragma("unroll") for (int n = 0; n < 2; ++n) _Pragma("unroll") for (int k = 0; k < 2; ++k) \
        acc[ai][bj][m][n] = __builtin_amdgcn_mfma_f32_16x16x32_bf16(Bt[n][k], At[m][k], acc[ai][bj][m][n], 0, 0, 0); __builtin_amdgcn_s_setprio(0); } while (0)
#define PG8_WAIT_V(n) asm volatile("s_waitcnt vmcnt(" #n ")" ::: "memory")
#define PG8_WAIT_L(n) asm volatile("s_waitcnt lgkmcnt(" #n ")" ::: "memory")
#define PG8_BAR __builtin_amdgcn_s_barrier()
#define PG8_SCHED __builtin_amdgcn_sched_barrier(0)
#define PG8_PA(u) ((const char*)P.base + (unsigned)tabv(P.tab, (u).g) + (size_t)(u).pm * tstep)
#define PG8_PB(u) ((const char*)P.base + (unsigned)tabv(P.tab, 4 + (u).g) + (size_t)(u).pn * tstep)
    Unit cur, nxt; int ui = 0;
    if (!S.next(0, cur)) return;
    f32x4 acc[2][2][4][2];
#pragma unroll
    for (int a = 0; a < 2; ++a)
#pragma unroll
        for (int b = 0; b < 2; ++b)
#pragma unroll
            for (int m = 0; m < 4; ++m)
#pragma unroll
                for (int n = 0; n < 2; ++n) acc[a][b][m][n] = (f32x4){0.f, 0.f, 0.f, 0.f};
    bf16x8 At[4][2], B0[2][2], B1[2][2];
    const char* cA = PG8_PA(cur); const char* cB = PG8_PB(cur);
    PG8_STAGE(PG8_SB(0, 0), cB, voffB); PG8_STAGE(PG8_SB(0, 1), cB + hstep, voffB); PG8_STAGE(PG8_SA(0, 0), cA, voffA); PG8_STAGE(PG8_SA(0, 1), cA + hstep, voffA);
    if (wr == 1) PG8_BAR;
    PG8_WAIT_V(2); PG8_BAR;
    PG8_STAGE(PG8_SB(1, 0), cB + kstep, voffB); PG8_STAGE(PG8_SA(1, 0), cA + kstep, voffA); PG8_STAGE(PG8_SB(1, 1), cB + hstep + kstep, voffB);
    PG8_WAIT_V(6); PG8_BAR;
    for (;;) {
        const bool has_next = S.next(ui + 1, nxt);
        const char* nA = cA; const char* nB = cB;
        if (has_next) { nA = PG8_PA(nxt); nB = PG8_PB(nxt); }
        for (int t = 0; t < nt; t += 2) {
            const bool last = (t == nt - 2);
            const char* a1 = cA + (size_t)(t + 1) * kstep;
            const char* a2 = last ? nA : cA + (size_t)(t + 2) * kstep; const char* b2 = last ? nB : cB + (size_t)(t + 2) * kstep;
            const char* a3 = a2 + kstep; const char* b3 = b2 + kstep;
            PG8_LDB(B0, 0, 0); PG8_LDB(B1, 0, 1); PG8_SCHED; PG8_LDA(At, 0, 0); PG8_STAGE(PG8_SA(1, 1), a1 + hstep, voffA);
            PG8_WAIT_V(8); PG8_WAIT_L(0); PG8_BAR; PG8_MMA(0, 0, At, B0); PG8_MMA(0, 1, At, B1); PG8_BAR; PG8_SCHED;
            PG8_LDA(At, 0, 1); PG8_STAGE(PG8_SB(0, 0), b2, voffB); PG8_STAGE(PG8_SB(0, 1), b2 + hstep, voffB); PG8_STAGE(PG8_SA(0, 0), a2, voffA);
            PG8_WAIT_V(8); PG8_WAIT_L(0); PG8_BAR; PG8_MMA(1, 0, At, B0); PG8_MMA(1, 1, At, B1); PG8_BAR; PG8_SCHED;
            PG8_LDB(B0, 1, 0); PG8_LDB(B1, 1, 1); PG8_SCHED; PG8_LDA(At, 1, 0); PG8_STAGE(PG8_SA(0, 1), a2 + hstep, voffA);
            PG8_WAIT_V(8); PG8_WAIT_L(0); PG8_BAR; PG8_MMA(0, 0, At, B0); PG8_MMA(0, 1, At, B1); PG8_BAR; PG8_SCHED;
            PG8_LDA(At, 1, 1); PG8_STAGE(PG8_SB(1, 0), b3, voffB); PG8_STAGE(PG8_SB(1, 1), b3 + hstep, voffB); PG8_STAGE(PG8_SA(1, 0), a3, voffA);
            PG8_WAIT_V(8); PG8_WAIT_L(0); PG8_BAR; PG8_MMA(1, 0, At, B0); PG8_MMA(1, 1, At, B1); PG8_BAR; PG8_SCHED;
        }
        if (wr == 0) PG8_BAR;
        E(acc, cur, wr, wc, fr, fq);
        if (!has_next) break;
#pragma unroll
        for (int a = 0; a < 2; ++a)
#pragma unroll
            for (int b = 0; b < 2; ++b)
#pragma unroll
                for (int m = 0; m < 4; ++m)
#pragma unroll
                    for (int n = 0; n < 2; ++n) acc[a][b][m][n] = (f32x4){0.f, 0.f, 0.f, 0.f};
        cur = nxt; cA = nA; cB = nB; ++ui;
        if (wr == 1) PG8_BAR;
    }
    PG8_WAIT_V(0);
    PG8_BAR;
#undef PG8_SA
#undef PG8_SB
#undef PG8_STAGE
#undef PG8_LDA
#undef PG8_LDB
#undef PG8_MMA
#undef PG8_WAIT_V
#undef PG8_WAIT_L
#undef PG8_BAR
#undef PG8_SCHED
#undef PG8_PA
#undef PG8_PB
}
}

constexpr int NWAVES = 8;
constexpr int D = 1024, NB = 8, SEQ = 2048, MP = NB * SEQ, DB = 128, DS = 8, MS = DB * DS, M = MP + MS;
constexpr int NH = 8, DK = 128, NMEM = 256, XH = 4, XD = 256, FF = 4096, NIN = 9232, NIN_T = 9216, MMEM = NB * NMEM;
constexpr float EPS = 1e-6f;
constexpr size_t O_Y = 0, O_MK = (size_t)M * D, O_MV = O_MK + (size_t)MMEM * D, O_GCP = O_MV + (size_t)MMEM * D, O_GSP = O_GCP + (size_t)NB * 3 * 3072,
                 O_SCP = O_GSP + (size_t)NB * NH * DK * DK, O_GCS = O_SCP + (size_t)NB * 2 * D, O_GSS = O_GCS + (size_t)DB * 3 * 3072, O_SCS = O_GSS + (size_t)DB * NH * DK * DK,
                 O_END = O_SCS + (size_t)DB * 2 * D;
static_assert(O_END == 41377792, "output size");

constexpr size_t MiB = 1u << 20;
constexpr size_t WS_CTL = 0, CTL_ZERO_BYTES = 1 * MiB;
constexpr size_t WS_WIN = 1 * MiB;
constexpr size_t WS_WGDNO = 19 * MiB, WS_WSCO = 21 * MiB, WS_WMIX = 23 * MiB, WS_WXQ = 25 * MiB, WS_WXO = 27 * MiB;
constexpr size_t WS_WXKV = 29 * MiB;
constexpr size_t WS_WUP = 33 * MiB;
constexpr size_t WS_WDN = 41 * MiB;
constexpr size_t WS_XN = 49 * MiB;
constexpr size_t WS_MN = 83 * MiB;
constexpr size_t WS_AB = 87 * MiB;
constexpr size_t WS_KB = 89 * MiB;
constexpr size_t WS_VT = 93 * MiB;
constexpr size_t WS_QKV = 97 * MiB;
constexpr size_t WS_UPRE = 199 * MiB, WS_SGA = 233 * MiB, WS_SGB = 267 * MiB;
constexpr size_t WS_R3 = 301 * MiB;
constexpr size_t WS_END = 445 * MiB;
constexpr size_t WS_YB = WS_QKV, WS_Q = WS_QKV, WS_MG = WS_R3, WS_CTX = WS_R3, WS_HB = WS_QKV;
constexpr size_t WS_SSQ = WS_SGA;
constexpr int CW_TMO = 0, CW_BAR = 4096;

#define GAS __attribute__((address_space(1)))
#define LAS __attribute__((address_space(3)))
typedef unsigned short bf16;
typedef unsigned v4u __attribute__((ext_vector_type(4)));
typedef unsigned v2u __attribute__((ext_vector_type(2)));
typedef float f32x4 __attribute__((ext_vector_type(4)));
typedef float f32x2 __attribute__((ext_vector_type(2)));
typedef short bf16x8 __attribute__((ext_vector_type(8)));
typedef __bf16 bf16x2_t __attribute__((ext_vector_type(2)));
typedef GAS unsigned gu32;
#define RLX_AGENT __ATOMIC_RELAXED, __HIP_MEMORY_SCOPE_AGENT
#define LDS_WAIT() asm volatile("s_waitcnt lgkmcnt(0)" ::: "memory")
#define VM_WAIT() asm volatile("s_waitcnt vmcnt(0)" ::: "memory")
__device__ __forceinline__ unsigned pk2(float lo, float hi) { f32x2 v = {lo, hi}; bf16x2_t b = __builtin_convertvector(v, bf16x2_t); return __builtin_bit_cast(unsigned, b); }
__device__ __forceinline__ float bf2f(unsigned short h) { return __uint_as_float((unsigned)h << 16); }
__device__ __forceinline__ float bflo(unsigned u) { return __uint_as_float(u << 16); }
__device__ __forceinline__ float bfhi(unsigned u) { return __uint_as_float(u & 0xffff0000u); }
__device__ __forceinline__ float sigmoidf_(float x) { return __builtin_amdgcn_rcpf(1.f + __builtin_amdgcn_exp2f(-1.4426950408889634f * x)); }
__device__ __forceinline__ float siluf_(float x) { return x * __builtin_amdgcn_rcpf(1.f + __builtin_amdgcn_exp2f(-1.4426950408889634f * x)); }
__device__ __forceinline__ float rsqf_(float x) { return __builtin_amdgcn_rsqf(x); }
template <int CTRL> __device__ __forceinline__ float dpp_f(float v) { return __builtin_bit_cast(float, __builtin_amdgcn_update_dpp(0, __builtin_bit_cast(int, v), CTRL, 0xf, 0xf, true)); }
__device__ __forceinline__ float half_sum(float v) { v += dpp_f<0xB1>(v); v += dpp_f<0x4E>(v); v += dpp_f<0x124>(v); v += dpp_f<0x128>(v); v += __shfl_xor(v, 16); return v; }

#define XB_TMO      128
#define XB_XCNT(j)  (256  + 64 * (j))
#define XB_XSUB(j)  (1280 + 64 * (j))
#define XB_XGEN(j)  (2304 + 64 * (j))
#define XB_TOP      3328
#define XB_TOPGEN   3392
#define XCD_BAR_WORDS 3456
#define XB_SPIN_CAP (1u << 18)
__device__ __forceinline__ unsigned xb_ld(unsigned* p)              { return __hip_atomic_load(p, __ATOMIC_RELAXED, __HIP_MEMORY_SCOPE_AGENT); }
__device__ __forceinline__ unsigned xb_add(unsigned* p, unsigned v) { return __hip_atomic_fetch_add(p, v, __ATOMIC_RELAXED, __HIP_MEMORY_SCOPE_AGENT); }
__device__ __forceinline__ unsigned xb_xcc_id() { return (unsigned)__builtin_amdgcn_s_getreg((3 << 11) | 20) & 0xFu; }
#define XB_SPIN(cond, bar) do { unsigned _sp = 0; while (cond) { __builtin_amdgcn_s_sleep(1); \
    if ((++_sp & 255u) == 0u) { if (xb_ld(&(bar)[XB_TMO])) break; if (_sp > XB_SPIN_CAP) { atomicAdd(&(bar)[XB_TMO], 1u); break; } } } } while (0)
struct XcdBarrier { unsigned* bar; unsigned x; volatile LAS unsigned* st; };
__device__ __forceinline__ XcdBarrier xcd_barrier_post(unsigned* bar, volatile LAS unsigned* st) {
    XcdBarrier b; b.bar = bar; b.x = xb_xcc_id(); b.st = st;
    if (threadIdx.x == 0) (void)xb_add(&bar[XB_XCNT(b.x)], 1u);
    return b;
}
__device__ __forceinline__ void xcd_barrier_complete(unsigned* bar, unsigned x, unsigned& nloc, unsigned& nx) {
    const unsigned G = gridDim.x * gridDim.y * gridDim.z;
    unsigned sum, cnt, mine, sp = 0u;
    for (;;) {
        sum = 0u; cnt = 0u; mine = 0u;
#pragma unroll
        for (unsigned j = 0; j < 16; ++j) { const unsigned c = xb_ld(&bar[XB_XCNT(j)]); sum += c; cnt += (c > 0u) ? 1u : 0u; mine = (j == x) ? c : mine; }
        if (sum == G) break;
        __builtin_amdgcn_s_sleep(1);
        if ((++sp & 255u) == 0u) { if (xb_ld(&bar[XB_TMO])) break; if (sp > XB_SPIN_CAP) { atomicAdd(&bar[XB_TMO], 1u); break; } }
    }
    nloc = mine > 0u ? mine : 1u; nx = cnt > 0u ? cnt : 1u;
}
__device__ __forceinline__ void xcd_barrier(const XcdBarrier& b) {
    asm volatile("s_waitcnt vmcnt(0)" ::: "memory");
    __syncthreads();
    if (threadIdx.x == 0) {
        unsigned* bar = b.bar;
        __builtin_amdgcn_s_waitcnt(0);
        unsigned nloc = b.st[0], nx = b.st[1];
        if (nloc == 0u) { xcd_barrier_complete(bar, b.x, nloc, nx); b.st[0] = nloc; b.st[1] = nx; }
        const unsigned old = xb_add(&bar[XB_XSUB(b.x)], 1u);
        const unsigned gen = old / nloc;
        if (old + 1u == (gen + 1u) * nloc) {
            __builtin_amdgcn_fence(__ATOMIC_RELEASE, "agent");
            asm volatile("s_waitcnt vmcnt(0)" ::: "memory");
            const unsigned og = xb_add(&bar[XB_TOP], 1u);
            const unsigned tg = og / nx;
            if (og + 1u == (tg + 1u) * nx) xb_add(&bar[XB_TOPGEN], 1u);
            else XB_SPIN(xb_ld(&bar[XB_TOPGEN]) == tg, bar);
            __builtin_amdgcn_fence(__ATOMIC_ACQUIRE, "agent");
            xb_add(&bar[XB_XGEN(b.x)], 1u);
            asm volatile("s_waitcnt vmcnt(0)" ::: "memory");
        } else {
            XB_SPIN(xb_ld(&bar[XB_XGEN(b.x)]) == gen, bar);
            __builtin_amdgcn_fence(__ATOMIC_ACQUIRE, "agent");
            asm volatile("s_waitcnt vmcnt(0)" ::: "memory");
        }
    }
    __syncthreads();
}

constexpr int RING_OFF = 0, RING_BYTES = 131072;
constexpr int LDSCTL_OFF = 147456, MISC_OFF = LDSCTL_OFF + 320, TAB_OFF = LDSCTL_OFF + 64;
constexpr int LDS_BYTES = 163840;

struct Args {
    const float* in[27]; float* out; unsigned char* ws; int ph_lo, ph_hi, li, pad;
};
enum { I_XP = 0, I_XS, I_MEM, I_CK, I_CV, I_SGC, I_SG, I_SSC, I_NMIX, I_WIN, I_GCW, I_ALOG, I_DTB, I_GON, I_WGDNO, I_SCW, I_WSCO, I_WMIX, I_NX, I_NMEM, I_WXQ, I_WXKV, I_WXO, I_NMLP, I_WUP, I_WDN, I_NF };

struct Frame {
    LAS unsigned char* lds; volatile LAS unsigned* MISC; gu32* ctl;
    int tid, lane, wave, vcu, G;
    const float* const* in; float* out; unsigned char* ws;
};
__device__ __forceinline__ float wave_sum(float v) {
#pragma unroll
    for (int o = 1; o < 64; o <<= 1) v += __shfl_xor(v, o);
    return v;
}

__device__ __forceinline__ void p0_transpose_block(const float* W, int ldw, int K, int k0, int src_col, bf16* WT, int dst_row, LAS float* scr, int lane) {
#pragma unroll 8
    for (int i = 0; i < 32; ++i) { const int kk = 2 * i + (lane >> 5); scr[kk * 33 + (lane & 31)] = W[(size_t)(k0 + kk) * ldw + src_col + (lane & 31)]; }
    LDS_WAIT(); asm volatile("" ::: "memory");
    const int c = lane & 7;
#pragma unroll
    for (int j = 0; j < 4; ++j) { const int n = (lane >> 3) + 8 * j; const LAS float* s = scr + (8 * c) * 33 + n;
        v4u o; o.x = pk2(s[0 * 33], s[1 * 33]); o.y = pk2(s[2 * 33], s[3 * 33]); o.z = pk2(s[4 * 33], s[5 * 33]); o.w = pk2(s[6 * 33], s[7 * 33]);
        *(GAS v4u*)(WT + (size_t)(dst_row + n) * K + k0 + 8 * c) = o; }
    LDS_WAIT(); asm volatile("" ::: "memory");
}
__device__ __forceinline__ int win_src_col(int n) {
    if (n < 4096) return n;
    if (n < 5120) return 4112 + (n - 4096);
    if (n < 7168) { const int t = (n - 5120) >> 8, w = (n - 5120) & 255; return (w < 128) ? (5136 + 128 * t + w) : (6160 + 128 * t + (w - 128)); }
    if (n < 8192) return 7184 + (n - 7168);
    return 8208 + (n - 8192);
}
__device__ __forceinline__ void p0_prologue(Frame& F) {
    LAS float* scr = (LAS float*)(F.lds + RING_OFF + F.wave * 16384);
    const int gw = F.vcu * NWAVES + F.wave, NGW = F.G * NWAVES;
    unsigned char* ws = F.ws;
    constexpr int I_IN = 16 * (NIN_T / 32), I_SQ = 16 * 32, I_KV = 16 * 64, I_UP = 16 * 128, I_DN = 64 * 32;
    constexpr int NITEMS = I_IN + 5 * I_SQ + I_KV + I_UP + I_DN;
    for (int it = gw; it < NITEMS; it += NGW) {
        int r = it;
        if (r < I_IN) { const int nb = r % (NIN_T / 32), kb = r / (NIN_T / 32); p0_transpose_block(F.in[I_WIN], NIN, D, 64 * kb, win_src_col(32 * nb), (bf16*)(ws + WS_WIN), 32 * nb, scr, F.lane); continue; } r -= I_IN;
        bool done = false;
#pragma unroll
        for (int q = 0; q < 5; ++q) {
            if (!done && r < I_SQ) { const int idx = (q == 0) ? I_WGDNO : (q == 1) ? I_WSCO : (q == 2) ? I_WMIX : (q == 3) ? I_WXQ : I_WXO;
                const size_t off = (q == 0) ? WS_WGDNO : (q == 1) ? WS_WSCO : (q == 2) ? WS_WMIX : (q == 3) ? WS_WXQ : WS_WXO;
                const int nb = r % 32, kb = r / 32; p0_transpose_block(F.in[idx], D, D, 64 * kb, 32 * nb, (bf16*)(ws + off), 32 * nb, scr, F.lane); done = true; }
            if (!done) r -= I_SQ;
        }
        if (done) continue;
        if (r < I_KV) { const int nb = r % 64, kb = r / 64; p0_transpose_block(F.in[I_WXKV], 2 * D, D, 64 * kb, 32 * nb, (bf16*)(ws + WS_WXKV), 32 * nb, scr, F.lane); continue; } r -= I_KV;
        if (r < I_UP) { const int nb = r % 128, kb = r / 128; p0_transpose_block(F.in[I_WUP], FF, D, 64 * kb, 32 * nb, (bf16*)(ws + WS_WUP), 32 * nb, scr, F.lane); continue; } r -= I_UP;
        { const int nb = r % 32, kb = r / 32; p0_transpose_block(F.in[I_WDN], D, FF, 64 * kb, 32 * nb, (bf16*)(ws + WS_WDN), 32 * nb, scr, F.lane); }
    }
    __syncthreads();
    LAS float* wab = (LAS float*)(F.lds + RING_OFF);
    for (int e = F.tid; e < 1024 * 4; e += NWAVES * 64) { const int k = e >> 2, q4 = e & 3; const int rho = ((k >> 2) & 63) + 64 * ((k & 3) + 4 * (k >> 8));
        const f32x4 v = *(const GAS f32x4*)(F.in[I_WIN] + (size_t)k * NIN + 4096 + 4 * q4); *(LAS f32x4*)(wab + rho * 20 + 4 * q4) = v; }
    __syncthreads();
    const float* gmix = F.in[I_NMIX];
    f32x4 gw4[4];
#pragma unroll
    for (int j = 0; j < 4; ++j) gw4[j] = *(const GAS f32x4*)(gmix + 4 * F.lane + 256 * j);
    for (int m = gw; m < M; m += NGW) {
        const float* xrow = (m < MP) ? F.in[I_XP] + (size_t)m * D : F.in[I_XS] + (size_t)(m - MP) * D;
        const GAS f32x4* xr = (const GAS f32x4*)xrow + F.lane;
        f32x4 v[4]; float s = 0.f;
#pragma unroll
        for (int j = 0; j < 4; ++j) { v[j] = xr[64 * j]; s += (v[j].x * v[j].x + v[j].y * v[j].y) + (v[j].z * v[j].z + v[j].w * v[j].w); }
        const float rs = 1.f / sqrtf(wave_sum(s) * (1.f / D) + EPS);
#pragma unroll
        for (int j = 0; j < 4; ++j) v[j] = v[j] * rs * gw4[j];
        GAS v2u* o8 = (GAS v2u*)((bf16*)(ws + WS_XN) + (size_t)m * D) + F.lane;
#pragma unroll
        for (int j = 0; j < 4; ++j) { v2u o; o.x = pk2(v[j].x, v[j].y); o.y = pk2(v[j].z, v[j].w); o8[64 * j] = o; }
        float p[16];
#pragma unroll
        for (int o = 0; o < 16; ++o) p[o] = 0.f;
#pragma unroll
        for (int j = 0; j < 4; ++j)
#pragma unroll
            for (int e = 0; e < 4; ++e) { const float hv = v[j][e]; const LAS f32x4* wr = (const LAS f32x4*)(wab + (F.lane + 64 * (e + 4 * j)) * 20);
#pragma unroll
                for (int q4 = 0; q4 < 4; ++q4) { const f32x4 w = wr[q4]; p[4 * q4 + 0] += hv * w.x; p[4 * q4 + 1] += hv * w.y; p[4 * q4 + 2] += hv * w.z; p[4 * q4 + 3] += hv * w.w; }
                if (e & 1) asm volatile("" ::: "memory"); }
        float q8[8], q4v[4], q2[2], q1;
        { const bool hi = (F.lane & 32) != 0;
#pragma unroll
          for (int i = 0; i < 8; ++i) { const float send = hi ? p[i] : p[i + 8], keep = hi ? p[i + 8] : p[i]; q8[i] = keep + __shfl_xor(send, 32); } }
        { const bool hi = (F.lane & 16) != 0;
#pragma unroll
          for (int i = 0; i < 4; ++i) { const float send = hi ? q8[i] : q8[i + 4], keep = hi ? q8[i + 4] : q8[i]; q4v[i] = keep + __shfl_xor(send, 16); } }
        { const bool hi = (F.lane & 8) != 0;
#pragma unroll
          for (int i = 0; i < 2; ++i) { const float send = hi ? q4v[i] : q4v[i + 2], keep = hi ? q4v[i + 2] : q4v[i]; q2[i] = keep + __shfl_xor(send, 8); } }
        { const bool hi = (F.lane & 4) != 0; const float send = hi ? q2[0] : q2[1], keep = hi ? q2[1] : q2[0]; q1 = keep + __shfl_xor(send, 4); }
        q1 += __shfl_xor(q1, 2); q1 += __shfl_xor(q1, 1);
        if ((F.lane & 3) == 0) ((GAS float*)(ws + WS_AB))[(size_t)m * 16 + (F.lane >> 2)] = q1;
    }
    const float* gmem = F.in[I_NMEM];
#pragma unroll
    for (int j = 0; j < 4; ++j) gw4[j] = *(const GAS f32x4*)(gmem + 4 * F.lane + 256 * j);
    for (int m = gw; m < MMEM; m += NGW) {
        const GAS f32x4* xr = (const GAS f32x4*)(F.in[I_MEM] + (size_t)m * D) + F.lane;
        f32x4 v[4]; float s = 0.f;
#pragma unroll
        for (int j = 0; j < 4; ++j) { v[j] = xr[64 * j]; s += (v[j].x * v[j].x + v[j].y * v[j].y) + (v[j].z * v[j].z + v[j].w * v[j].w); }
        const float rs = 1.f / sqrtf(wave_sum(s) * (1.f / D) + EPS);
        GAS v2u* o8 = (GAS v2u*)((bf16*)(ws + WS_MN) + (size_t)m * D) + F.lane;
#pragma unroll
        for (int j = 0; j < 4; ++j) { const f32x4 h = v[j] * rs * gw4[j]; v2u o; o.x = pk2(h.x, h.y); o.y = pk2(h.z, h.w); o8[64 * j] = o; }
    }
    __syncthreads();
}

struct EpiP1 {
    unsigned char* ws; float* out;
    __device__ __forceinline__ void operator()(const pg8::f32x4 (&acc)[2][2][4][2], const pg8::Unit& u, int wr, int wc, int fr, int fq) const {
        bf16* const qkv = (bf16*)(ws + WS_QKV); bf16* const sz = (bf16*)(out + O_Y); bf16* const bg = sz + (size_t)M * D; bf16* const upre = (bf16*)(ws + WS_UPRE);
        bf16* const sga = (bf16*)(ws + WS_SGA); bf16* const sgb = (bf16*)(ws + WS_SGB); bf16* const kb = (bf16*)(ws + WS_KB); bf16* const vt = (bf16*)(ws + WS_VT);
        float* const mk = out + O_MK; float* const mv = out + O_MV;
        const int row0 = u.pm * 256 + wr * 64 + fr, cl = wc * 32 + 8 * fq;
        if (u.g == 0) {
            const int pn = u.pn;
            if (pn >= 20 && pn < 28) {
#pragma unroll
                for (int ai = 0; ai < 2; ++ai)
#pragma unroll
                    for (int m = 0; m < 4; ++m) { const size_t r = (size_t)(row0 + ai * 128 + m * 16);
                        const f32x4 a0 = acc[ai][0][m][0] * acc[ai][1][m][0], a1 = acc[ai][0][m][1] * acc[ai][1][m][1];
                        v4u w; w.x = pk2(a0[0], a0[1]); w.y = pk2(a0[2], a0[3]); w.z = pk2(a1[0], a1[1]); w.w = pk2(a1[2], a1[3]);
                        *(GAS v4u*)(upre + r * D + 128 * (pn - 20) + cl) = w; }
                return;
            }
            bf16* base; int ld, c0, act;
            if (pn < 12) { base = qkv; ld = 3072; c0 = 256 * pn; act = 0; }
            else if (pn < 16) { base = sz; ld = D; c0 = 256 * (pn - 12); act = 1; }
            else if (pn < 20) { base = bg; ld = D; c0 = 256 * (pn - 16); act = 0; }
            else if (pn < 32) { base = sga; ld = D; c0 = 256 * (pn - 28); act = 2; }
            else { base = sgb; ld = D; c0 = 256 * (pn - 32); act = 2; }
#pragma unroll
            for (int ai = 0; ai < 2; ++ai)
#pragma unroll
                for (int m = 0; m < 4; ++m) { bf16* rowp = base + (size_t)(row0 + ai * 128 + m * 16) * ld + c0 + cl;
#pragma unroll
                    for (int bj = 0; bj < 2; ++bj) { f32x4 v0 = acc[ai][bj][m][0], v1 = acc[ai][bj][m][1];
                        if (act == 1) {
#pragma unroll
                            for (int e = 0; e < 4; ++e) { v0[e] = siluf_(v0[e]); v1[e] = siluf_(v1[e]); } }
                        else if (act == 2) {
#pragma unroll
                            for (int e = 0; e < 4; ++e) { v0[e] = sigmoidf_(v0[e]); v1[e] = sigmoidf_(v1[e]); } }
                        v4u w; w.x = pk2(v0[0], v0[1]); w.y = pk2(v0[2], v0[3]); w.z = pk2(v1[0], v1[1]); w.w = pk2(v1[2], v1[3]);
                        *(GAS v4u*)(rowp + bj * 128) = w; } }
        } else if (u.g == 1) {
            const bool isk = u.pn < 4; float* fo = isk ? mk : mv; const int c0 = 256 * (u.pn & 3) + cl;
#pragma unroll
            for (int ai = 0; ai < 2; ++ai)
#pragma unroll
                for (int m = 0; m < 4; ++m) { const size_t r = (size_t)(row0 + ai * 128 + m * 16);
#pragma unroll
                    for (int bj = 0; bj < 2; ++bj) { const f32x4 v0 = acc[ai][bj][m][0], v1 = acc[ai][bj][m][1];
                        *(GAS f32x4*)(fo + r * D + c0 + bj * 128) = v0; *(GAS f32x4*)(fo + r * D + c0 + bj * 128 + 4) = v1;
                        if (isk) { v4u w; w.x = pk2(v0[0], v0[1]); w.y = pk2(v0[2], v0[3]); w.z = pk2(v1[0], v1[1]); w.w = pk2(v1[2], v1[3]);
                            *(GAS v4u*)(kb + r * D + c0 + bj * 128) = w; } } }
        } else {
#pragma unroll
            for (int ai = 0; ai < 2; ++ai)
#pragma unroll
                for (int m = 0; m < 4; ++m) { const size_t r = (size_t)(row0 + ai * 128 + m * 16);
#pragma unroll
                    for (int bj = 0; bj < 2; ++bj) { const int c = 256 * u.pn + bj * 128 + cl;
                        const int b3 = (c >> 3) & 1, cb = c & ~15; const f32x4 v0 = acc[ai][bj][m][0], v1 = acc[ai][bj][m][1];
                        v2u w0, w1; w0.x = pk2(v0[0], v0[1]); w0.y = pk2(v0[2], v0[3]); w1.x = pk2(v1[0], v1[1]); w1.y = pk2(v1[2], v1[3]);
                        *(GAS v2u*)(vt + r * MMEM + cb + 4 * b3) = w0; *(GAS v2u*)(vt + r * MMEM + cb + 8 + 4 * b3) = w1; } }
        }
    }
};


#if MK_TIMING
#define PSTAMP(k) do { if (u == 512 && F.tid == 0) __hip_atomic_store(F.ctl + 1024 + 2 * (20 + (k)), (unsigned)(__builtin_amdgcn_s_memrealtime()), RLX_AGENT); } while (0)
#else
#define PSTAMP(k) do {} while (0)
#endif
typedef float f32x16 __attribute__((ext_vector_type(16)));
#define MFMA32(a, b, c) __builtin_amdgcn_mfma_f32_32x32x16_bf16((a), (b), (c), 0, 0, 0)
__device__ __forceinline__ int crow(int reg, int h) { return (reg & 3) + 8 * (reg >> 2) + 4 * h; }
__device__ __forceinline__ bf16x8 pack_step(const f32x16& x, int s) {
    v4u p; p.x = pk2(x[8 * s + 0], x[8 * s + 1]); p.y = pk2(x[8 * s + 2], x[8 * s + 3]); p.z = pk2(x[8 * s + 4], x[8 * s + 5]); p.w = pk2(x[8 * s + 6], x[8 * s + 7]);
    return __builtin_bit_cast(bf16x8, p);
}
__device__ __forceinline__ float softplusf_(float x) { return x > 20.f ? x : log1pf(__expf(x)); }
constexpr int CH_W = 0, CH_QE = 16384, CH_KE = 32768, CH_UV = 49152, CH_P = 65536, CH_BYTES = 73728;
constexpr size_t WS_GT = WS_AB + 1536 * 1024;
constexpr size_t WS_O = WS_XN;
constexpr int PL_VF = 0, PL_KB = 32768, PL_QB = 50176, PL_LM = 67584, PL_GC = 83968, PL_BT = PL_GC + 256, PL_EG = PL_BT + 256;
constexpr int KBS = 136;

constexpr int PL2_KB = 0, PL2_QB = 17408, PL2_RT = 34816, PL2_GC = 71680, PL2_BT = PL2_GC + 256, PL2_EG = PL2_BT + 256, PL2_BYTES = 72704;
constexpr int RTS = 72, TMS = 68;
__device__ __forceinline__ void gdn_prep_unit(Frame& F, int pu) {
    const int grp = F.wave >> 2, w = F.wave & 3, lane = F.lane;
    const int u = 2 * pu + grp, b = u >> 8, h = (u >> 5) & 7, c = u & 31;
    const size_t row0 = (size_t)b * SEQ + 64 * c;
    unsigned char* ws = F.ws;
    LAS unsigned char* lb = F.lds + grp * PL2_BYTES;
    LAS bf16* kb = (LAS bf16*)(lb + PL2_KB); LAS bf16* qb = (LAS bf16*)(lb + PL2_QB); LAS bf16* rt = (LAS bf16*)(lb + PL2_RT);
    LAS float* Lt = (LAS float*)(lb + PL2_KB); LAS float* Tm = (LAS float*)(lb + PL2_QB);
    LAS float* gcs = (LAS float*)(lb + PL2_GC); LAS float* bts = (LAS float*)(lb + PL2_BT); LAS float* egs = (LAS float*)(lb + PL2_EG);
    unsigned char* rec = ws + WS_R3 + (size_t)u * CH_BYTES;
    PSTAMP(5);
    if (w == 0) {
        const float* ab = (const float*)(ws + WS_AB) + (row0 + lane) * 16;
        const float a = ab[h], bb = ab[8 + h];
        float g = -__expf(F.in[I_ALOG][h]) * softplusf_(a + F.in[I_DTB][h]);
        float gc = g;
#pragma unroll
        for (int o = 1; o < 64; o <<= 1) { const float t = __shfl_up(gc, o); if (lane >= o) gc += t; }
        gcs[lane] = gc; bts[lane] = sigmoidf_(bb); egs[lane] = __expf(gc);
    }
    __syncthreads();
    PSTAMP(6);
    {
        const int cg = lane & 31, rp = lane >> 5;
        const float gl = gcs[63];
        const bf16* qkv = (const bf16*)(ws + WS_QKV);
#pragma unroll
        for (int p = 0; p < 3; ++p) {
            const int colb = p * 1024 + h * 128 + 4 * cg;
            f32x4 wv[4];
#pragma unroll
            for (int i = 0; i < 4; ++i) wv[i] = *(const GAS f32x4*)(F.in[I_GCW] + (size_t)i * 3072 + colb);
            v2u raw[2][7];
#pragma unroll
            for (int k = 0; k < 2; ++k)
#pragma unroll
                for (int r = 0; r < 7; ++r) { const int i0 = 16 * w + 8 * k + 4 * rp; const int t = 64 * c + i0 - 3 + r;
                    raw[k][r] = (v2u){0u, 0u}; if (t >= 0) raw[k][r] = *(const GAS v2u*)(qkv + (row0 + i0 - 3 + r) * 3072 + colb); }
#pragma unroll
            for (int k = 0; k < 2; ++k) {
                const int i0 = 16 * w + 8 * k + 4 * rp;
                float x[7][4];
#pragma unroll
                for (int r = 0; r < 7; ++r) { x[r][0] = bflo(raw[k][r].x); x[r][1] = bfhi(raw[k][r].x); x[r][2] = bflo(raw[k][r].y); x[r][3] = bfhi(raw[k][r].y); }
                float y[4][4];
#pragma unroll
                for (int ro = 0; ro < 4; ++ro)
#pragma unroll
                    for (int e = 0; e < 4; ++e) { float a = 0.f;
#pragma unroll
                        for (int i = 0; i < 4; ++i) a += wv[i][e] * x[ro + i][e];
                        y[ro][e] = siluf_(a); }
                if (p < 2) {
#pragma unroll
                    for (int ro = 0; ro < 4; ++ro) { const float ss = half_sum((y[ro][0] * y[ro][0] + y[ro][1] * y[ro][1]) + (y[ro][2] * y[ro][2] + y[ro][3] * y[ro][3]));
                        const float sc = rsqf_(ss + 1e-6f) * (p == 0 ? 0.08838834764831845f : 1.f);
#pragma unroll
                        for (int e = 0; e < 4; ++e) y[ro][e] *= sc; }
                }
                if (p == 0) {
#pragma unroll
                    for (int ro = 0; ro < 4; ++ro) { const int i = i0 + ro; v2u o; o.x = pk2(y[ro][0], y[ro][1]); o.y = pk2(y[ro][2], y[ro][3]);
                        *(LAS v2u*)(qb + i * KBS + 4 * cg) = o;
                        const float eg = egs[i]; v2u q; q.x = pk2(y[ro][0] * eg, y[ro][1] * eg); q.y = pk2(y[ro][2] * eg, y[ro][3] * eg);
                        const int rb = i >> 5, db = cg >> 3, s2 = (cg >> 2) & 1, a2 = (cg >> 1) & 1, hh = cg & 1;
                        *(GAS v2u*)(rec + CH_QE + ((((rb * 4 + db) * 2 + s2) * 64 + (i & 31) + 32 * hh) * 8 + 4 * a2) * 2) = q; }
                } else {
                    float sk[4], ek[4];
#pragma unroll
                    for (int ro = 0; ro < 4; ++ro) { const int i = i0 + ro; sk[ro] = bts[i] * (p == 1 ? egs[i] : 1.f); ek[ro] = __expf(gl - gcs[i]); }
                    if (p == 1) {
#pragma unroll
                        for (int ro = 0; ro < 4; ++ro) { const int i = i0 + ro; v2u o; o.x = pk2(y[ro][0], y[ro][1]); o.y = pk2(y[ro][2], y[ro][3]);
                            *(LAS v2u*)(kb + i * KBS + 4 * cg) = o; }
                        const int rb = i0 >> 5, rho = i0 & 31, s2 = (rho >> 4) & 1, a2 = (rho >> 3) & 1, hh = (rho >> 2) & 1, db = cg >> 3;
#pragma unroll
                        for (int e = 0; e < 4; ++e) { const int r = 4 * (cg & 7) + e; v2u o; o.x = pk2(y[0][e] * ek[0], y[1][e] * ek[1]); o.y = pk2(y[2][e] * ek[2], y[3][e] * ek[3]);
                            *(GAS v2u*)(rec + CH_KE + ((((db * 2 + rb) * 2 + s2) * 64 + r + 32 * hh) * 8 + 4 * a2) * 2) = o; }
                    }
#pragma unroll
                    for (int e = 0; e < 4; ++e) { v2u o; o.x = pk2(y[0][e] * sk[0], y[1][e] * sk[1]); o.y = pk2(y[2][e] * sk[2], y[3][e] * sk[3]);
                        *(LAS v2u*)(rt + ((p - 1) * 128 + 4 * cg + e) * RTS + i0) = o; }
                }
            }
        }
    }
    __syncthreads();
    PSTAMP(7);
    const int ti = (w == 0) ? 0 : 1, tj = (w == 2) ? 1 : 0, r = lane & 31, hh = lane >> 5;
    f32x16 acc, accp;
#pragma unroll
    for (int i = 0; i < 16; ++i) { acc[i] = 0.f; accp[i] = 0.f; }
    if (w < 3) {
#pragma unroll
        for (int s2 = 0; s2 < 8; ++s2) {
            const bf16x8 ki = *(const LAS bf16x8*)(kb + (32 * ti + r) * KBS + 16 * s2 + 8 * hh);
            const bf16x8 kj = *(const LAS bf16x8*)(kb + (32 * tj + r) * KBS + 16 * s2 + 8 * hh);
            const bf16x8 qi = *(const LAS bf16x8*)(qb + (32 * ti + r) * KBS + 16 * s2 + 8 * hh);
            acc = MFMA32(ki, kj, acc);
            accp = MFMA32(kj, qi, accp);
        }
    }
    __syncthreads();
    if (w < 3) {
        int r_ = lane & 31, hh_ = lane >> 5; asm volatile("" : "+v"(r_), "+v"(hh_));
        const int r = r_, hh = hh_;
        {
            const int j = 32 * tj + r; const float gcj = gcs[j];
#pragma unroll
            for (int g4 = 0; g4 < 4; ++g4) { f32x4 o;
#pragma unroll
                for (int e = 0; e < 4; ++e) { const int i = 32 * ti + crow(4 * g4 + e, hh); o[e] = (i > j) ? bts[i] * acc[4 * g4 + e] * __expf(fminf(gcs[i] - gcj, 0.f)) : 0.f; }
                *(LAS f32x4*)(Lt + j * 64 + 32 * ti + 8 * g4 + 4 * hh) = o; }
        }
        {   const int i = 32 * ti + r; const float gci = gcs[i];
#pragma unroll
            for (int q = 0; q < 16; ++q) { const int j = 32 * tj + crow(q, hh); accp[q] = (i >= j) ? accp[q] * __expf(fminf(gci - gcs[j], 0.f)) : 0.f; }
#pragma unroll
            for (int s2 = 0; s2 < 2; ++s2) *(GAS bf16x8*)(rec + CH_P + (((ti * 2 + tj) * 2 + s2) * 64 + lane) * 16) = pack_step(accp, s2);
        }
    }
    __syncthreads();
    PSTAMP(8);
    if (w == 0) {
        const int cc = lane & 31, hf = lane >> 5;
        unsigned ltb = (unsigned)(size_t)(Lt + hf * (32 * 64 + 32)); asm volatile("" : "+v"(ltb)); const LAS float* Lp = (const LAS float*)ltb;
        float x[32];
#pragma unroll
        for (int i = 0; i < 32; ++i) x[i] = (i == cc) ? 1.f : 0.f;
#pragma unroll
        for (int j = 0; j < 31; ++j) {
            const float xj = x[j];
#pragma unroll
            for (int i4 = (j + 1) / 4; i4 < 8; ++i4) { const f32x4 l = *(const LAS f32x4*)(Lp + j * 64 + 4 * i4);
#pragma unroll
                for (int e = 0; e < 4; ++e) { const int i = 4 * i4 + e; if (i > j) x[i] -= l[e] * xj; } }
            if ((j & 3) == 3) asm volatile("" ::: "memory");
        }
        unsigned tmb = (unsigned)(size_t)(Tm + hf * (32 * TMS + 32) + cc); asm volatile("" : "+v"(tmb)); LAS float* Tp = (LAS float*)tmb;
#pragma unroll
        for (int i = 0; i < 32; ++i) Tp[i * TMS] = x[i];
        if (hf == 1) {
#pragma unroll
            for (int i = 0; i < 32; ++i) Tp[i * TMS - 32 * TMS] = 0.f;
        }
    }
    __syncthreads();
    if (w == 0) {
        f32x16 m1, t10;
#pragma unroll
        for (int i = 0; i < 16; ++i) { m1[i] = 0.f; t10[i] = 0.f; }
#pragma unroll
        for (int s2 = 0; s2 < 16; ++s2) m1 = __builtin_amdgcn_mfma_f32_32x32x2f32(Lt[(2 * s2 + hh) * 64 + 32 + r], Tm[(2 * s2 + hh) * TMS + r], m1, 0, 0, 0);
#pragma unroll
        for (int q = 0; q < 16; ++q) t10 = __builtin_amdgcn_mfma_f32_32x32x2f32(Tm[(32 + r) * TMS + 32 + crow(q, hh)], m1[q], t10, 0, 0, 0);
#pragma unroll
        for (int q = 0; q < 16; ++q) Tm[(32 + crow(q, hh)) * TMS + r] = -t10[q];
    }
    __syncthreads();
    PSTAMP(9);
#pragma unroll
    for (int cs = 0; cs < 2; ++cs) {
        const int ct = 2 * w + cs;
#pragma unroll
        for (int rb = 0; rb < 2; ++rb) {
            f32x16 a;
#pragma unroll
            for (int i = 0; i < 16; ++i) a[i] = 0.f;
#pragma unroll
            for (int s2 = 0; s2 < 4; ++s2) if (s2 < 2 || rb == 1) {
                const LAS float* tp = Tm + (32 * rb + r) * TMS + 16 * s2 + 8 * hh;
                const f32x4 t0 = *(const LAS f32x4*)tp, t1 = *(const LAS f32x4*)(tp + 4);
                const v4u tv = {pk2(t0[0], t0[1]), pk2(t0[2], t0[3]), pk2(t1[0], t1[1]), pk2(t1[2], t1[3])};
                const bf16x8 tf = __builtin_bit_cast(bf16x8, tv);
                const bf16x8 rf = *(const LAS bf16x8*)(rt + (32 * ct + r) * RTS + 16 * s2 + 8 * hh);
                a = (ct < 4) ? MFMA32(rf, tf, a) : MFMA32(tf, rf, a);
            }
            if (ct < 4) {
#pragma unroll
                for (int s2 = 0; s2 < 2; ++s2) *(GAS bf16x8*)(rec + CH_W + (((rb * 4 + ct) * 2 + s2) * 64 + lane) * 16) = pack_step(a, s2);
            } else {
#pragma unroll
                for (int g4 = 0; g4 < 4; ++g4) *(GAS v2u*)(rec + CH_UV + (((rb * 4 + (ct - 4)) * 4 + g4) * 64 + lane) * 8) = (v2u){pk2(a[4 * g4], a[4 * g4 + 1]), pk2(a[4 * g4 + 2], a[4 * g4 + 3])};
            }
        }
    }
    if ((F.tid & 255) == 0) ((GAS float*)(ws + WS_GT))[u] = egs[63];
    __syncthreads();
    PSTAMP(10);
}

__device__ __forceinline__ void gdn_sample_unit(Frame& F, int su) {
    const int sl = __builtin_amdgcn_readfirstlane(F.tid >> 7), cc = F.tid & 127, sq = 4 * su + sl, b = sq >> 3, h = sq & 7;
    unsigned char* ws = F.ws;
    LAS float* base = (LAS float*)(F.lds + sl * 16384);
    LAS float* qs = base, *ks = base + 1024, *vs = base + 2048, *egs = base + 3072, *bts = base + 3088;
    const bf16* qkv = (const bf16*)(ws + WS_QKV);
    const size_t rowb = (size_t)MP + (size_t)b * DS;
#pragma unroll
    for (int p = 0; p < 3; ++p) {
        const int col = p * 1024 + h * 128 + cc; float xx[11];
#pragma unroll
        for (int r = 0; r < 3; ++r) xx[r] = F.in[I_SGC][((size_t)b * 3 + r) * 3072 + col];
#pragma unroll
        for (int t = 0; t < 8; ++t) xx[3 + t] = bf2f(qkv[(rowb + t) * 3072 + col]);
        float wv[4];
#pragma unroll
        for (int i = 0; i < 4; ++i) wv[i] = F.in[I_GCW][(size_t)i * 3072 + col];
        LAS float* dst = (p == 0) ? qs : (p == 1) ? ks : vs;
#pragma unroll
        for (int t = 0; t < 8; ++t) { const float a = wv[0] * xx[t] + wv[1] * xx[t + 1] + wv[2] * xx[t + 2] + wv[3] * xx[t + 3]; dst[t * 128 + cc] = siluf_(a); }
    }
    if (cc < 8) { const float* ab = (const float*)(ws + WS_AB) + (rowb + cc) * 16;
        const float g = -__expf(F.in[I_ALOG][h]) * softplusf_(ab[h] + F.in[I_DTB][h]); egs[cc] = __expf(g); bts[cc] = sigmoidf_(ab[8 + h]); }
    float S[128];
    const float* s0 = F.in[I_SG] + ((size_t)(b * 8 + h) * 128) * 128 + cc;
#pragma unroll
    for (int dk = 0; dk < 128; ++dk) S[dk] = s0[(size_t)dk * 128];
    __syncthreads();
    for (int t = 0; t < 8; ++t) {
        float ssk = 0.f, kS = 0.f;
#pragma unroll
        for (int d4 = 0; d4 < 32; ++d4) { const f32x4 kv = *(const LAS f32x4*)(ks + t * 128 + 4 * d4);
#pragma unroll
            for (int e = 0; e < 4; ++e) { ssk += kv[e] * kv[e]; kS += S[4 * d4 + e] * kv[e]; }
            if ((d4 & 3) == 3) asm volatile("" ::: "memory"); }
        const float rk = 1.f / sqrtf(ssk + 1e-6f), eg = egs[t];
        const float uu = bts[t] * (vs[t * 128 + cc] - eg * kS * rk) * rk;
        float ssq = 0.f, o = 0.f;
#pragma unroll
        for (int d4 = 0; d4 < 32; ++d4) { const f32x4 kv = *(const LAS f32x4*)(ks + t * 128 + 4 * d4); const f32x4 qv = *(const LAS f32x4*)(qs + t * 128 + 4 * d4);
#pragma unroll
            for (int e = 0; e < 4; ++e) { const float sn = eg * S[4 * d4 + e] + kv[e] * uu; S[4 * d4 + e] = sn; ssq += qv[e] * qv[e]; o += sn * qv[e]; }
            if ((d4 & 1) == 1) asm volatile("" ::: "memory"); }
        o *= (1.f / sqrtf(ssq + 1e-6f)) * 0.08838834764831845f;
        ((bf16*)(ws + WS_O))[(rowb + t) * D + h * 128 + cc] = (bf16)(pk2(o, 0.f) & 0xffffu);
    }
    float* so = F.out + O_GSS + ((size_t)(b * 8 + h) * 128) * 128 + cc;
#pragma unroll
    for (int dk = 0; dk < 128; ++dk) so[(size_t)dk * 128] = S[dk];
    __syncthreads();
}

__device__ __forceinline__ void sc_conv_pass(Frame& F) {
    const bf16* upre = (const bf16*)(F.ws + WS_UPRE); bf16* bgp = (bf16*)(F.out + O_Y) + (size_t)M * D;
    const size_t gt = (size_t)F.vcu * (NWAVES * 64) + F.tid, NT = (size_t)F.G * NWAVES * 64;
    for (size_t it = gt; it < (size_t)M * 128; it += NT) {
        const size_t row = it >> 7; const int c8 = (int)(it & 127) * 8;
        const bool smp = row >= MP; const int t = smp ? (int)((row - MP) & 7) : (int)(row & (SEQ - 1)); const int sb = smp ? (int)((row - MP) >> 3) : 0;
        float xm[3][8];
        { const v4u r = *(const GAS v4u*)(upre + row * D + c8); xm[2][0] = bflo(r.x); xm[2][1] = bfhi(r.x); xm[2][2] = bflo(r.y); xm[2][3] = bfhi(r.y); xm[2][4] = bflo(r.z); xm[2][5] = bfhi(r.z); xm[2][6] = bflo(r.w); xm[2][7] = bfhi(r.w); }
#pragma unroll
        for (int k = 1; k <= 2; ++k) {
            if (t - k >= 0) { const v4u r = *(const GAS v4u*)(upre + (row - k) * D + c8);
                xm[2 - k][0] = bflo(r.x); xm[2 - k][1] = bfhi(r.x); xm[2 - k][2] = bflo(r.y); xm[2 - k][3] = bfhi(r.y); xm[2 - k][4] = bflo(r.z); xm[2 - k][5] = bfhi(r.z); xm[2 - k][6] = bflo(r.w); xm[2 - k][7] = bfhi(r.w); }
            else if (smp) { const float* sp = F.in[I_SSC] + ((size_t)sb * 2 + (2 + t - k)) * D + c8;
#pragma unroll
                for (int e = 0; e < 8; ++e) xm[2 - k][e] = sp[e]; }
            else {
#pragma unroll
                for (int e = 0; e < 8; ++e) xm[2 - k][e] = 0.f; }
        }
        const v4u br = *(const GAS v4u*)(bgp + row * D + c8);
        float bgv[8] = {bflo(br.x), bfhi(br.x), bflo(br.y), bfhi(br.y), bflo(br.z), bfhi(br.z), bflo(br.w), bfhi(br.w)};
        float o[8];
#pragma unroll
        for (int e = 0; e < 8; ++e) { const float w0 = F.in[I_SCW][c8 + e], w1 = F.in[I_SCW][D + c8 + e], w2 = F.in[I_SCW][2 * D + c8 + e];
            o[e] = bgv[e] * (w0 * xm[0][e] + w1 * xm[1][e] + w2 * xm[2][e]); }
        *(GAS v4u*)(bgp + row * D + c8) = (v4u){pk2(o[0], o[1]), pk2(o[2], o[3]), pk2(o[4], o[5]), pk2(o[6], o[7])};
    }
}

__device__ __forceinline__ void gdn_scan_unit(Frame& F, int bh) {
    unsigned char* ws = F.ws; const int lane = F.lane, dvl = lane & 31, hh = lane >> 5, w = F.wave;
    const int b = bh >> 3, h = bh & 7;
    const unsigned char* rec0 = ws + WS_R3 + (size_t)bh * 32 * CH_BYTES;
    const unsigned l16 = (unsigned)lane * 16u;
    __syncthreads();
    if (w >= 4) {
        const int lw = w - 4;
#pragma unroll
        for (int k = 0; k < 18; ++k) { const int pz = lw * 18 + k;
            __builtin_amdgcn_global_load_lds((const unsigned*)(rec0 + (size_t)pz * 1024 + l16), (LAS unsigned*)(F.lds + pz * 1024), 16, 0, 0); }
        asm volatile("s_waitcnt vmcnt(0)" ::: "memory");
    }
    __syncthreads();
    f32x16 S[4];
#pragma unroll
    for (int d = 0; d < 4; ++d)
#pragma unroll
        for (int i = 0; i < 16; ++i) S[d][i] = 0.f;
    const float gtv = ((const GAS float*)(ws + WS_GT))[bh * 32 + (lane & 31)];
    bf16* Og = (bf16*)(ws + WS_O);
    const int vsl = w & 3;
    for (int c = 0; c < 32; ++c) {
        if (w >= 4) {
            if (c + 1 < 32 && MK_EXP != 2) { const int lw = w - 4; const unsigned char* rn = rec0 + (size_t)(c + 1) * CH_BYTES; const int bo = ((c + 1) & 1) * CH_BYTES;
#pragma unroll
                for (int k = 0; k < 18; ++k) { const int pz = lw * 18 + k;
                    __builtin_amdgcn_global_load_lds((const unsigned*)(rn + (size_t)pz * 1024 + l16), (LAS unsigned*)(F.lds + bo + pz * 1024), 16, 0, 0); }
                asm volatile("s_waitcnt vmcnt(0)" ::: "memory"); }
        } else if (MK_EXP != 1) {
            const LAS unsigned char* rec = F.lds + (c & 1) * CH_BYTES + l16;
            const float gt = __shfl(gtv, c);
            bf16x8 Sb[4][2];
#pragma unroll
            for (int d = 0; d < 4; ++d) { Sb[d][0] = pack_step(S[d], 0); Sb[d][1] = pack_step(S[d], 1); }
            f32x16 U[2];
#pragma unroll
            for (int rb = 0; rb < 2; ++rb) {
                f32x16 a;
#pragma unroll
                for (int i = 0; i < 16; ++i) a[i] = 0.f;
#pragma unroll
                for (int d = 0; d < 4; ++d)
#pragma unroll
                    for (int s2 = 0; s2 < 2; ++s2) a = MFMA32(*(const LAS bf16x8*)(rec + (CH_W + ((rb * 4 + d) * 2 + s2) * 1024)), Sb[d][s2], a);
                const LAS unsigned char* uvp = F.lds + (c & 1) * CH_BYTES + CH_UV + (rb * 16 + vsl * 4) * 512 + lane * 8;
#pragma unroll
                for (int g4 = 0; g4 < 4; ++g4) { const v2u uv = *(const LAS v2u*)(uvp + g4 * 512);
                    a[4 * g4 + 0] = bflo(uv.x) - a[4 * g4 + 0]; a[4 * g4 + 1] = bfhi(uv.x) - a[4 * g4 + 1]; a[4 * g4 + 2] = bflo(uv.y) - a[4 * g4 + 2]; a[4 * g4 + 3] = bfhi(uv.y) - a[4 * g4 + 3]; }
                U[rb] = a;
                asm volatile("" ::: "memory");
            }
            bf16x8 Ub[2][2];
#pragma unroll
            for (int rb = 0; rb < 2; ++rb) { Ub[rb][0] = pack_step(U[rb], 0); Ub[rb][1] = pack_step(U[rb], 1); }
#pragma unroll
            for (int rb = 0; rb < 2; ++rb) {
                f32x16 o;
#pragma unroll
                for (int i = 0; i < 16; ++i) o[i] = 0.f;
#pragma unroll
                for (int d = 0; d < 4; ++d)
#pragma unroll
                    for (int s2 = 0; s2 < 2; ++s2) o = MFMA32(*(const LAS bf16x8*)(rec + (CH_QE + ((rb * 4 + d) * 2 + s2) * 1024)), Sb[d][s2], o);
#pragma unroll
                for (int tj = 0; tj < 2; ++tj) if (tj <= rb)
#pragma unroll
                    for (int s2 = 0; s2 < 2; ++s2) o = MFMA32(*(const LAS bf16x8*)(rec + (CH_P + ((rb * 2 + tj) * 2 + s2) * 1024)), Ub[tj][s2], o);
                bf16* op = Og + ((size_t)b * SEQ + 64 * c + 32 * rb + 4 * hh) * D + h * 128 + 32 * vsl + dvl; asm volatile("" : "+v"(op));
#pragma unroll
                for (int q = 0; q < 16; ++q) op[(size_t)((q & 3) + 8 * (q >> 2)) * D] = (bf16)(pk2(o[q], 0.f) & 0xffffu);
                asm volatile("" ::: "memory");
            }
#pragma unroll
            for (int d = 0; d < 4; ++d) {
                f32x16 a = S[d] * gt;
#pragma unroll
                for (int rb = 0; rb < 2; ++rb)
#pragma unroll
                    for (int s2 = 0; s2 < 2; ++s2) a = MFMA32(*(const LAS bf16x8*)(rec + (CH_KE + ((d * 2 + rb) * 2 + s2) * 1024)), Ub[rb][s2], a);
                S[d] = a;
                if (d & 1) asm volatile("" ::: "memory");
            }
        }
        __syncthreads();
    }
    if (w < 4) {
        float* so = F.out + O_GSP + ((size_t)bh * 128 + 4 * hh) * 128 + 32 * vsl + dvl; asm volatile("" : "+v"(so));
#pragma unroll
        for (int d = 0; d < 4; ++d)
#pragma unroll
            for (int q = 0; q < 16; ++q) so[(size_t)(32 * d + (q & 3) + 8 * (q >> 2)) * 128] = S[d][q];
    }
}

__device__ __forceinline__ void og_pass(Frame& F) {
    bf16* Og = (bf16*)(F.ws + WS_O); const bf16* sz = (const bf16*)(F.out + O_Y);
    const int gw = F.vcu * NWAVES + F.wave, NGW = F.G * NWAVES;
    const float w0 = F.in[I_GON][2 * F.lane], w1 = F.in[I_GON][2 * F.lane + 1];
    for (int m = gw; m < M; m += NGW) {
        unsigned ov[8], zv[8];
#pragma unroll
        for (int hd = 0; hd < 8; ++hd) { ov[hd] = *(const GAS unsigned*)(Og + (size_t)m * D + hd * 128 + 2 * F.lane); zv[hd] = *(const GAS unsigned*)(sz + (size_t)m * D + hd * 128 + 2 * F.lane); }
#pragma unroll
        for (int hd = 0; hd < 8; ++hd) { const float a = bflo(ov[hd]), bq = bfhi(ov[hd]);
            const float rs = 1.f / sqrtf(wave_sum(a * a + bq * bq) * (1.f / 128.f) + EPS);
            *(GAS unsigned*)(Og + (size_t)m * D + hd * 128 + 2 * F.lane) = pk2(a * rs * w0 * bflo(zv[hd]), bq * rs * w1 * bfhi(zv[hd])); }
    }
}


__device__ __forceinline__ void unpack8(const v4u r, float (&o)[8]) { o[0] = bflo(r.x); o[1] = bfhi(r.x); o[2] = bflo(r.y); o[3] = bfhi(r.y); o[4] = bflo(r.z); o[5] = bfhi(r.z); o[6] = bflo(r.w); o[7] = bfhi(r.w); }
struct EpiP3 {
    unsigned char* ws;
    __device__ __forceinline__ void operator()(const pg8::f32x4 (&acc)[2][2][4][2], const pg8::Unit& u, int wr, int wc, int fr, int fq) const {
        const bf16* gate = (const bf16*)(ws + (u.g == 0 ? WS_SGB : WS_SGA)); bf16* yb = (bf16*)(ws + WS_YB); bf16* mg = (bf16*)(ws + WS_MG);
        const int row0 = u.pm * 256 + wr * 64 + fr, col0 = u.pn * 256 + wc * 32 + 8 * fq;
#pragma unroll
        for (int ai = 0; ai < 2; ++ai)
#pragma unroll
            for (int m = 0; m < 4; ++m) { const size_t ro = (size_t)(row0 + ai * 128 + m * 16) * D + col0;
#pragma unroll
                for (int bj = 0; bj < 2; ++bj) { float gv[8]; unpack8(*(const GAS v4u*)(gate + ro + bj * 128), gv);
                    float v[8];
#pragma unroll
                    for (int e = 0; e < 4; ++e) { v[e] = acc[ai][bj][m][0][e] * gv[e]; v[4 + e] = acc[ai][bj][m][1][e] * gv[4 + e]; }
                    if (u.g == 1) { float y[8]; unpack8(*(const GAS v4u*)(yb + ro + bj * 128), y);
#pragma unroll
                        for (int e = 0; e < 8; ++e) v[e] += y[e]; }
                    const v4u w = {pk2(v[0], v[1]), pk2(v[2], v[3]), pk2(v[4], v[5]), pk2(v[6], v[7])};
                    *(GAS v4u*)((u.g == 0 ? yb : mg) + ro + bj * 128) = w; } }
    }
};
template <bool FIRST> struct EpiRes {
    const float* xp; const float* xsmp; float* xo; const float* gain; bf16* an; float* ssq; bool write_a;
    __device__ __forceinline__ void operator()(const pg8::f32x4 (&acc)[2][2][4][2], const pg8::Unit& u, int wr, int wc, int fr, int fq) const {
        const int row0 = u.pm * 256 + wr * 64 + fr, col0 = u.pn * 256 + wc * 32 + 8 * fq;
        f32x4 gv[2][2];
#pragma unroll
        for (int bj = 0; bj < 2; ++bj) { gv[bj][0] = *(const GAS f32x4*)(gain + col0 + bj * 128); gv[bj][1] = *(const GAS f32x4*)(gain + col0 + bj * 128 + 4); }
#pragma unroll
        for (int ai = 0; ai < 2; ++ai)
#pragma unroll
            for (int m = 0; m < 4; ++m) { const int row = row0 + ai * 128 + m * 16; const size_t ro = (size_t)row * D + col0;
                const float* src = FIRST ? ((row < MP) ? xp + ro : xsmp + (ro - (size_t)MP * D)) : xo + ro;
                float ss = 0.f;
#pragma unroll
                for (int bj = 0; bj < 2; ++bj) {
                    const f32x4 x0 = *(const GAS f32x4*)(src + bj * 128) + acc[ai][bj][m][0], x1 = *(const GAS f32x4*)(src + bj * 128 + 4) + acc[ai][bj][m][1];
                    *(GAS f32x4*)(xo + ro + bj * 128) = x0; *(GAS f32x4*)(xo + ro + bj * 128 + 4) = x1;
                    ss += (x0[0] * x0[0] + x0[1] * x0[1]) + (x0[2] * x0[2] + x0[3] * x0[3]) + (x1[0] * x1[0] + x1[1] * x1[1]) + (x1[2] * x1[2] + x1[3] * x1[3]);
                    if (write_a) { const f32x4 a0 = x0 * gv[bj][0], a1 = x1 * gv[bj][1];
                        *(GAS v4u*)(an + ro + bj * 128) = (v4u){pk2(a0[0], a0[1]), pk2(a0[2], a0[3]), pk2(a1[0], a1[1]), pk2(a1[2], a1[3])}; } }
                ss += __shfl_xor(ss, 16); ss += __shfl_xor(ss, 32);
                if (fq == 0) ssq[(size_t)row * 16 + u.pn * 4 + wc] = ss; }
    }
};
__device__ __forceinline__ float row_rs(const float* ssq, int row) {
    const f32x4 a = *(const GAS f32x4*)(ssq + (size_t)row * 16), b = *(const GAS f32x4*)(ssq + (size_t)row * 16 + 4), c = *(const GAS f32x4*)(ssq + (size_t)row * 16 + 8), d = *(const GAS f32x4*)(ssq + (size_t)row * 16 + 12);
    const float s = ((a[0] + a[1]) + (a[2] + a[3])) + ((b[0] + b[1]) + (b[2] + b[3])) + ((c[0] + c[1]) + (c[2] + c[3])) + ((d[0] + d[1]) + (d[2] + d[3]));
    return 1.f / sqrtf(s * (1.f / D) + EPS);
}
template <int ACT> struct EpiScale {
    const float* ssq; bf16* o; int ldc; float scale;
    __device__ __forceinline__ void operator()(const pg8::f32x4 (&acc)[2][2][4][2], const pg8::Unit& u, int wr, int wc, int fr, int fq) const {
        const int row0 = u.pm * 256 + wr * 64 + fr, col0 = u.pn * 256 + wc * 32 + 8 * fq;
#pragma unroll
        for (int ai = 0; ai < 2; ++ai)
#pragma unroll
            for (int m = 0; m < 4; ++m) { const int row = row0 + ai * 128 + m * 16; const float rs = row_rs(ssq, row) * scale;
#pragma unroll
                for (int bj = 0; bj < 2; ++bj) { f32x4 v0 = acc[ai][bj][m][0] * rs, v1 = acc[ai][bj][m][1] * rs;
                    if (ACT == 1) {
#pragma unroll
                        for (int e = 0; e < 4; ++e) { const float a = fmaxf(v0[e], 0.f), b = fmaxf(v1[e], 0.f); v0[e] = a * a; v1[e] = b * b; } }
                    *(GAS v4u*)(o + (size_t)row * ldc + col0 + bj * 128) = (v4u){pk2(v0[0], v0[1]), pk2(v0[2], v0[3]), pk2(v1[0], v1[1]), pk2(v1[2], v1[3])}; } }
    }
};

__device__ __forceinline__ void attn_prompt_unit(Frame& F, int u) {
    unsigned char* ws = F.ws; const int lane = F.lane, r = lane & 31, hh = lane >> 5;
    const int qt = u & 7, head = (u >> 3) & 3, b = u >> 5;
    const size_t row0 = (size_t)b * SEQ + qt * 256 + 32 * F.wave;
    const bf16* Q = (const bf16*)(ws + WS_Q) + (row0 + r) * D + head * 256 + 8 * hh;
    const bf16* Kp = (const bf16*)(ws + WS_KB) + ((size_t)b * NMEM + r) * D + head * 256 + 8 * hh;
    const bf16* Vp = (const bf16*)(ws + WS_VT) + ((size_t)head * 256 + r) * MMEM + (size_t)b * NMEM + 8 * hh;
    f32x16 acc[8];
#pragma unroll
    for (int kt = 0; kt < 8; ++kt)
#pragma unroll
        for (int i = 0; i < 16; ++i) acc[kt][i] = 0.f;
#pragma unroll
    for (int s2 = 0; s2 < 16; ++s2) {
        const bf16x8 bq = *(const GAS bf16x8*)(Q + 16 * s2);
#pragma unroll
        for (int kt = 0; kt < 8; ++kt) acc[kt] = MFMA32(*(const GAS bf16x8*)(Kp + (size_t)kt * 32 * D + 16 * s2), bq, acc[kt]);
        asm volatile("" ::: "memory");
    }
    float mx = -1e30f;
#pragma unroll
    for (int kt = 0; kt < 8; ++kt)
#pragma unroll
        for (int i = 0; i < 16; ++i) mx = fmaxf(mx, acc[kt][i]);
    mx = fmaxf(mx, __shfl_xor(mx, 32));
    float l = 0.f;
#pragma unroll
    for (int kt = 0; kt < 8; ++kt)
#pragma unroll
        for (int i = 0; i < 16; ++i) { const float pv = __expf(acc[kt][i] - mx); acc[kt][i] = pv; l += pv; }
    l += __shfl_xor(l, 32);
    const float il = 1.f / l;
    bf16x8 Pb[8][2];
#pragma unroll
    for (int kt = 0; kt < 8; ++kt) { Pb[kt][0] = pack_step(acc[kt], 0); Pb[kt][1] = pack_step(acc[kt], 1); }
    bf16* ctx = (bf16*)(ws + WS_CTX) + (row0 + r) * D + head * 256 + 4 * hh;
#pragma unroll
    for (int dt = 0; dt < 8; ++dt) {
        f32x16 o;
#pragma unroll
        for (int i = 0; i < 16; ++i) o[i] = 0.f;
#pragma unroll
        for (int kt = 0; kt < 8; ++kt) {
#pragma unroll
            for (int s2 = 0; s2 < 2; ++s2) o = MFMA32(*(const GAS bf16x8*)(Vp + (size_t)dt * 32 * MMEM + 32 * kt + 16 * s2), Pb[kt][s2], o);
            if ((kt & 3) == 3) asm volatile("" ::: "memory"); }
#pragma unroll
        for (int g4 = 0; g4 < 4; ++g4) *(GAS v2u*)(ctx + 32 * dt + 8 * g4) = (v2u){pk2(o[4 * g4] * il, o[4 * g4 + 1] * il), pk2(o[4 * g4 + 2] * il, o[4 * g4 + 3] * il)};
        asm volatile("" ::: "memory");
    }
}
__device__ __forceinline__ void attn_sample_pass(Frame& F, int bp) {
    unsigned char* ws = F.ws; const int lane = F.lane, r = lane & 31, hh = lane >> 5;
    const int ul = F.wave >> 2, ds = F.wave & 3, unit = 2 * bp + ul, sb = unit >> 2, head = unit & 3;
    const float* Kc = F.in[I_CK] + (((size_t)sb * NMEM + r) * XH + head) * XD + 64 * ds + 8 * hh;
    const float* Vc = F.in[I_CV] + (((size_t)sb * NMEM) * XH + head) * XD + 64 * ds + r;
    const bf16* Q = (const bf16*)(ws + WS_Q) + ((size_t)MP + (size_t)sb * DS + (r & 7)) * D + head * 256 + 64 * ds + 8 * hh;
    f32x16 acc[8];
#pragma unroll
    for (int kt = 0; kt < 8; ++kt)
#pragma unroll
        for (int i = 0; i < 16; ++i) acc[kt][i] = 0.f;
#pragma unroll
    for (int s2 = 0; s2 < 4; ++s2) {
        bf16x8 bq = *(const GAS bf16x8*)(Q + 16 * s2);
        if (r >= 8) bq = (bf16x8){0, 0, 0, 0, 0, 0, 0, 0};
#pragma unroll
        for (int kt = 0; kt < 8; ++kt) { const float* kp = Kc + (size_t)kt * 32 * XH * XD + 16 * s2; asm volatile("" : "+v"(kp));
            const f32x4 k0 = *(const GAS f32x4*)kp, k1 = *(const GAS f32x4*)(kp + 4);
            const v4u ka = {pk2(k0[0], k0[1]), pk2(k0[2], k0[3]), pk2(k1[0], k1[1]), pk2(k1[2], k1[3])};
            acc[kt] = MFMA32(__builtin_bit_cast(bf16x8, ka), bq, acc[kt]);
            if (kt & 1) asm volatile("" ::: "memory"); }
    }
    LAS float* part = (LAS float*)(F.lds + ul * 32768);
    if (r < 8) {
#pragma unroll
        for (int kt = 0; kt < 8; ++kt)
#pragma unroll
            for (int i = 0; i < 16; ++i) part[(ds * 256 + 32 * kt + crow(i, hh)) * 8 + r] = acc[kt][i];
    }
    __syncthreads();
#pragma unroll
    for (int kt = 0; kt < 8; ++kt)
#pragma unroll
        for (int i = 0; i < 16; ++i) { float sv = 0.f;
            if (r < 8) { const int o = (32 * kt + crow(i, hh)) * 8 + r; sv = (part[o] + part[2048 + o]) + (part[4096 + o] + part[6144 + o]); }
            acc[kt][i] = sv; }
    float mx = -1e30f;
#pragma unroll
    for (int kt = 0; kt < 8; ++kt)
#pragma unroll
        for (int i = 0; i < 16; ++i) mx = fmaxf(mx, acc[kt][i]);
    mx = fmaxf(mx, __shfl_xor(mx, 32));
    float l = 0.f;
#pragma unroll
    for (int kt = 0; kt < 8; ++kt)
#pragma unroll
        for (int i = 0; i < 16; ++i) { const float pv = __expf(acc[kt][i] - mx); acc[kt][i] = pv; l += pv; }
    l += __shfl_xor(l, 32);
    const float il = 1.f / l;
    bf16x8 Pb[8][2];
#pragma unroll
    for (int kt = 0; kt < 8; ++kt) { Pb[kt][0] = pack_step(acc[kt], 0); Pb[kt][1] = pack_step(acc[kt], 1); }
    bf16* ctx = (bf16*)(ws + WS_CTX) + ((size_t)MP + (size_t)sb * DS + (r & 7)) * D + head * 256 + 64 * ds + 4 * hh;
#pragma unroll
    for (int dt = 0; dt < 2; ++dt) {
        f32x16 o;
#pragma unroll
        for (int i = 0; i < 16; ++i) o[i] = 0.f;
#pragma unroll
        for (int kt = 0; kt < 8; ++kt) {
#pragma unroll
            for (int s2 = 0; s2 < 2; ++s2) { float vv[8]; const float* vk = Vc + (size_t)(32 * kt + 16 * s2 + 4 * hh) * XH * XD + 32 * dt; asm volatile("" : "+v"(vk));
#pragma unroll
                for (int j = 0; j < 8; ++j) vv[j] = vk[(size_t)(8 * (j >> 2) + (j & 3)) * XH * XD];
                const v4u va = {pk2(vv[0], vv[1]), pk2(vv[2], vv[3]), pk2(vv[4], vv[5]), pk2(vv[6], vv[7])};
                o = MFMA32(__builtin_bit_cast(bf16x8, va), Pb[kt][s2], o); }
            asm volatile("" ::: "memory"); }
        if (r < 8) {
#pragma unroll
            for (int g4 = 0; g4 < 4; ++g4) *(GAS v2u*)(ctx + 32 * dt + 8 * g4) = (v2u){pk2(o[4 * g4] * il, o[4 * g4 + 1] * il), pk2(o[4 * g4 + 2] * il, o[4 * g4 + 3] * il)};
        }
    }
    __syncthreads();
}
__device__ __forceinline__ void final_norm_pass(Frame& F) {
    const float* ssq = (const float*)(F.ws + WS_SSQ) + 2 * (size_t)M * 16; float* y = F.out + O_Y;
    const int gw = F.vcu * NWAVES + F.wave, NGW = F.G * NWAVES;
    f32x4 gw4[4];
#pragma unroll
    for (int j = 0; j < 4; ++j) gw4[j] = *(const GAS f32x4*)(F.in[I_NF] + 4 * F.lane + 256 * j);
    for (int m = gw; m < M; m += NGW) { const float rs = row_rs(ssq, m); GAS f32x4* yr = (GAS f32x4*)(y + (size_t)m * D) + F.lane;
#pragma unroll
        for (int j = 0; j < 4; ++j) yr[64 * j] = yr[64 * j] * rs * gw4[j]; }
}

__device__ __forceinline__ void copy_conv_states(Frame& F) {
    const bf16* qkv = (const bf16*)(F.ws + WS_QKV); const bf16* upre = (const bf16*)(F.ws + WS_UPRE);
    const int gt = F.vcu * (NWAVES * 64) + F.tid, NT = F.G * NWAVES * 64;
    const int n1 = (NB + DB) * 3 * 3072;
    for (int e = gt; e < n1; e += NT) { const int c = e % 3072, r = (e / 3072) % 3, s = e / (3 * 3072);
        const size_t row = (s < NB) ? (size_t)s * SEQ + (SEQ - 3 + r) : (size_t)MP + (size_t)(s - NB) * DS + (DS - 3 + r);
        const float v = bf2f(qkv[row * 3072 + c]);
        if (s < NB) F.out[O_GCP + ((size_t)s * 3 + r) * 3072 + c] = v; else F.out[O_GCS + ((size_t)(s - NB) * 3 + r) * 3072 + c] = v; }
    const int n2 = (NB + DB) * 2 * D;
    for (int e = gt; e < n2; e += NT) { const int c = e % D, r = (e / D) % 2, s = e / (2 * D);
        const size_t row = (s < NB) ? (size_t)s * SEQ + (SEQ - 2 + r) : (size_t)MP + (size_t)(s - NB) * DS + (DS - 2 + r);
        const float v = bf2f(upre[row * D + c]);
        if (s < NB) F.out[O_SCP + ((size_t)s * 2 + r) * D + c] = v; else F.out[O_SCS + ((size_t)(s - NB) * 2 + r) * D + c] = v; }
}


#if MK_DEBUG
constexpr int CW_CHK = 512;
__device__ __forceinline__ unsigned hash_u(unsigned x) { x ^= x >> 16; x *= 0x7feb352du; x ^= x >> 15; x *= 0x846ca68bu; x ^= x >> 16; return x; }
__device__ __forceinline__ void chk_put(Frame& F, int ch, float got, float ref, float floor_) {
    float e = (got - ref) * (got - ref); if (!(e == e) || e > 1e30f) e = 1e30f;
    atomicAdd((float*)(F.ctl + CW_CHK + 2 * ch), e); atomicAdd((float*)(F.ctl + CW_CHK + 2 * ch + 1), ref * ref);
}
__device__ __forceinline__ float bfround(float x) { return bflo(pk2(x, 0.f) & 0xffffu); }
#if 0
__device__ __forceinline__ void debug_checks(Frame& F) {
    const unsigned gt = (unsigned)(F.vcu * (NWAVES * 64) + F.tid);
    unsigned char* ws = F.ws;
    const bf16* win = (const bf16*)(ws + WS_WIN); const bf16* xn = (const bf16*)(ws + WS_XN); const bf16* mn = (const bf16*)(ws + WS_MN);
    const bf16* wxkv = (const bf16*)(ws + WS_WXKV);
    { const unsigned h = hash_u(gt * 3u + 1u); const int n = h % NIN_T, k = (h >> 16) % D;
      chk_put(F, 0, bf2f(win[(size_t)n * D + k]), bfround(F.in[I_WIN][(size_t)k * NIN + win_src_col(n)]), 1e-6f);
      const int n2 = h % 2048; chk_put(F, 0, bf2f(wxkv[(size_t)n2 * D + k]), bfround(F.in[I_WXKV][(size_t)k * 2048 + n2]), 1e-6f);
      const int n3 = h % 1024, k3 = (h >> 12) % FF; chk_put(F, 0, bf2f(((const bf16*)(ws + WS_WDN))[(size_t)n3 * FF + k3]), bfround(F.in[I_WDN][(size_t)k3 * D + n3]), 1e-6f);
      const int n4 = h % FF; chk_put(F, 0, bf2f(((const bf16*)(ws + WS_WUP))[(size_t)n4 * D + k]), bfround(F.in[I_WUP][(size_t)k * FF + n4]), 1e-6f);
      chk_put(F, 0, bf2f(((const bf16*)(ws + WS_WXO))[(size_t)n3 * D + k]), bfround(F.in[I_WXO][(size_t)k * D + n3]), 1e-6f);
      chk_put(F, 0, bf2f(((const bf16*)(ws + WS_WGDNO))[(size_t)n3 * D + k]), bfround(F.in[I_WGDNO][(size_t)k * D + n3]), 1e-6f); }
    if (gt < 4096) { const unsigned h = hash_u(gt * 7u + 5u); const int m = h % M; const float* xr = (m < MP) ? F.in[I_XP] + (size_t)m * D : F.in[I_XS] + (size_t)(m - MP) * D;
      float s = 0.f; for (int k = 0; k < D; ++k) s += xr[k] * xr[k]; const float rs = 1.f / sqrtf(s / D + EPS); const int k0 = (h >> 16) % D;
      chk_put(F, 1, bf2f(xn[(size_t)m * D + k0]), xr[k0] * rs * F.in[I_NMIX][k0], 1e-3f);
      const int o = (h >> 8) & 15; float a = 0.f; for (int k = 0; k < D; ++k) a += xr[k] * rs * F.in[I_NMIX][k] * F.in[I_WIN][(size_t)k * NIN + 4096 + o];
      chk_put(F, 2, ((const float*)(ws + WS_AB))[(size_t)m * 16 + o], a, 1e-2f);
      const int mm = h % MMEM; const float* mr = F.in[I_MEM] + (size_t)mm * D; s = 0.f; for (int k = 0; k < D; ++k) s += mr[k] * mr[k]; const float rs2 = 1.f / sqrtf(s / D + EPS);
      chk_put(F, 1, bf2f(mn[(size_t)mm * D + k0]), mr[k0] * rs2 * F.in[I_NMEM][k0], 1e-3f); }
    if (gt < 16384) { const unsigned h = hash_u(gt * 11u + 3u); const int m = h % M, n = (h >> 9) % NIN_T;
      float d = 0.f; for (int k = 0; k < D; ++k) d += bf2f(xn[(size_t)m * D + k]) * bf2f(win[(size_t)n * D + k]);
      const int pn = n >> 8, c = n & 255;
      if (pn < 12) chk_put(F, 3, bf2f(((const bf16*)(ws + WS_QKV))[(size_t)m * 3072 + n]), d, 2e-2f);
      else if (pn < 16) chk_put(F, 4, bf2f(((const bf16*)(F.out + O_Y))[(size_t)m * D + (n - 3072)]), d / (1.f + expf(-d)), 2e-2f);
      else if (pn < 20) chk_put(F, 4, bf2f((((const bf16*)(F.out + O_Y)) + (size_t)M * D)[(size_t)m * D + (n - 4096)]), d, 2e-2f);
      else if (pn < 28) { const int n2 = (c < 128) ? n + 128 : n - 128; float d2 = 0.f; for (int k = 0; k < D; ++k) d2 += bf2f(xn[(size_t)m * D + k]) * bf2f(win[(size_t)n2 * D + k]);
          chk_put(F, 5, bf2f(((const bf16*)(ws + WS_UPRE))[(size_t)m * D + 128 * (pn - 20) + (c & 127)]), d * d2, 2e-2f); }
      else if (pn < 32) chk_put(F, 4, bf2f(((const bf16*)(ws + WS_SGA))[(size_t)m * D + (n - 7168)]), 1.f / (1.f + expf(-d)), 2e-2f);
      else chk_put(F, 4, bf2f(((const bf16*)(ws + WS_SGB))[(size_t)m * D + (n - 8192)]), 1.f / (1.f + expf(-d)), 2e-2f);
      const int mm = h % MMEM, nn = (h >> 11) % 2048; float dk = 0.f; for (int k = 0; k < D; ++k) dk += bf2f(mn[(size_t)mm * D + k]) * bf2f(wxkv[(size_t)nn * D + k]);
      if (nn < 1024) { chk_put(F, 6, F.out[O_MK + (size_t)mm * D + nn], dk, 2e-2f); chk_put(F, 6, bf2f(((const bf16*)(ws + WS_KB))[(size_t)mm * D + nn]), dk, 2e-2f); }
      else { chk_put(F, 6, F.out[O_MV + (size_t)mm * D + (nn - 1024)], dk, 2e-2f);
          const int key = mm & 255, kp = (key & ~12) | ((key & 4) << 1) | ((key & 8) >> 1);
          chk_put(F, 7, bf2f(((const bf16*)(ws + WS_VT))[(size_t)(nn - 1024) * MMEM + (mm & ~255) + kp]), dk, 2e-2f); } }
}

#endif
__device__ __forceinline__ void debug_checks(Frame& F) {
    const unsigned gt = (unsigned)(F.vcu * (NWAVES * 64) + F.tid);
    unsigned char* ws = F.ws;
    if (gt < 512) { const int idx = gt >> 3, hd = gt & 7; const int m = hash_u(idx * 29u + 11u) % M; const bf16* og = (const bf16*)(ws + WS_O); const bf16* sz = (const bf16*)(F.out + O_Y);
        const bf16* osv = (const bf16*)(ws + WS_END - 2 * MiB) + (size_t)idx * D + hd * 128;
        float ss = 0.f; for (int dv = 0; dv < 128; ++dv) { const float o = bf2f(osv[dv]); ss += o * o; } const float rs = 1.f / sqrtf(ss / 128.f + EPS);
        for (int dv = 0; dv < 128; ++dv) chk_put(F, 1, bf2f(og[(size_t)m * D + hd * 128 + dv]), bf2f(osv[dv]) * rs * F.in[I_GON][dv] * bf2f(sz[(size_t)m * D + hd * 128 + dv]), 0.f); }
    if (gt < 16384) { const unsigned h = hash_u(gt * 11u + 3u); const int m = h % M, c = (h >> 15) % D; const bf16* xn0 = nullptr; (void)xn0;
        const bf16* upre = (const bf16*)(ws + WS_UPRE); const bf16* ub = (const bf16*)(F.out + O_Y) + (size_t)M * D;
        const bool smp = m >= MP; const int t = smp ? ((m - MP) & 7) : (m & (SEQ - 1)); const int sb = smp ? ((m - MP) >> 3) : 0;
        float conv = 0.f; for (int k = 0; k < 3; ++k) { const int tt = t - 2 + k; float xv = 0.f; if (tt >= 0) xv = bf2f(upre[(size_t)(m - 2 + k) * D + c]); else if (smp) xv = F.in[I_SSC][((size_t)sb * 2 + (2 + tt)) * D + c]; conv += F.in[I_SCW][(size_t)k * D + c] * xv; }
        const float* xr = (m < MP) ? F.in[I_XP] + (size_t)m * D : F.in[I_XS] + (size_t)(m - MP) * D; float ss = 0.f; for (int k = 0; k < D; ++k) ss += xr[k] * xr[k]; const float rs = 1.f / sqrtf(ss / D + EPS);
        float bgv = 0.f; for (int k = 0; k < D; ++k) bgv += xr[k] * rs * F.in[I_NMIX][k] * F.in[I_WIN][(size_t)k * NIN + 4112 + c];
        chk_put(F, 2, bf2f(ub[(size_t)m * D + c]), bgv * conv, 3e-2f); }
}
__device__ __forceinline__ void naive_gdn_col(Frame& F, size_t rowb, int T, const float* hist, const float* S0  , int h, int dv, float* Scol  , int ch, bool check_o) {
    const bf16* qkv = (const bf16*)(F.ws + WS_QKV); const float* gcw = F.in[I_GCW]; const bf16* Og = (const bf16*)(F.ws + WS_O);
    for (int dk = 0; dk < 128; ++dk) Scol[dk] = S0 ? S0[(size_t)dk * 128 + dv] : 0.f;
    const float eA = expf(F.in[I_ALOG][h]), dtb = F.in[I_DTB][h];
    for (int t = 0; t < T; ++t) {
        float ssk = 0.f, ssq = 0.f, kS = 0.f;
        for (int pass = 0; pass < 2; ++pass) {
            float o = 0.f, rk = 0.f, rq = 0.f, uu = 0.f, eg = 0.f;
            if (pass == 1) {
                rk = 1.f / sqrtf(ssk + 1e-6f); rq = 1.f / sqrtf(ssq + 1e-6f) * 0.08838834764831845f;
                const float* ab = (const float*)(F.ws + WS_AB) + (rowb + t) * 16;
                const float g = -eA * log1pf(expf(ab[h] + dtb)); eg = expf(g); const float beta = 1.f / (1.f + expf(-ab[8 + h]));
                float vv = 0.f; { const int col = 2048 + h * 128 + dv; for (int i = 0; i < 4; ++i) { const int tt = t - 3 + i; const float xv = (tt >= 0) ? bf2f(qkv[(rowb + tt) * 3072 + col]) : (hist ? hist[(size_t)(3 + tt) * 3072 + col] : 0.f); vv += gcw[(size_t)i * 3072 + col] * xv; } vv = vv / (1.f + expf(-vv)); }
                uu = beta * (vv - eg * kS * rk);
            }
            for (int dk = 0; dk < 128; ++dk) {
                float kv = 0.f, qv = 0.f;
                for (int i = 0; i < 4; ++i) { const int tt = t - 3 + i; const int ck = 1024 + h * 128 + dk, cq = h * 128 + dk;
                    const float xk = (tt >= 0) ? bf2f(qkv[(rowb + tt) * 3072 + ck]) : (hist ? hist[(size_t)(3 + tt) * 3072 + ck] : 0.f);
                    const float xq = (tt >= 0) ? bf2f(qkv[(rowb + tt) * 3072 + cq]) : (hist ? hist[(size_t)(3 + tt) * 3072 + cq] : 0.f);
                    kv += gcw[(size_t)i * 3072 + ck] * xk; qv += gcw[(size_t)i * 3072 + cq] * xq; }
                kv = kv / (1.f + expf(-kv)); qv = qv / (1.f + expf(-qv));
                if (pass == 0) { ssk += kv * kv; ssq += qv * qv; kS += Scol[dk] * kv; }
                else { Scol[dk] = eg * Scol[dk] + kv * rk * uu; o += Scol[dk] * qv * rq; }
            }
            if (pass == 1 && check_o && (t % 61 == 0 || t == T - 1)) chk_put(F, ch - 5, bf2f(Og[(rowb + t) * D + h * 128 + dv]), o, 2e-2f);
        }
    }
}
__device__ __forceinline__ void debug_checks_gdn(Frame& F) {
    float* scr = (float*)(F.ws + WS_END - 4 * MiB);
    const unsigned gt = (unsigned)(F.vcu * (NWAVES * 64) + F.tid);
    if (gt < 64) {
        const unsigned hsh = hash_u(gt * 13u + 7u); const int b = hsh % DB, h = (hsh >> 8) & 7, dv = (hsh >> 12) & 127;
        float* Scol = scr + (size_t)gt * 128;
        naive_gdn_col(F, (size_t)MP + (size_t)b * DS, DS, F.in[I_SGC] + (size_t)b * 3 * 3072, F.in[I_SG] + (size_t)(b * 8 + h) * 128 * 128, h, dv, Scol, 8, true);
        for (int dk = 0; dk < 128; ++dk) chk_put(F, 8, F.out[O_GSS + ((size_t)(b * 8 + h) * 128 + dk) * 128 + dv], Scol[dk], 1e-3f);
    } else if (gt >= 1024 && gt < 1024 + 64) {
        const int idx = gt - 1024; const int m = hash_u(idx * 29u + 11u) % M; const bf16* Og = (const bf16*)(F.ws + WS_O); bf16* osv = (bf16*)(F.ws + WS_END - 2 * MiB) + (size_t)idx * D;
        for (int k = 0; k < D; ++k) osv[k] = Og[(size_t)m * D + k];
    } else if (gt >= 512 && gt < 512 + 32) {
        const unsigned hsh = hash_u(gt * 17u + 3u); const int b = hsh % NB, h = (hsh >> 8) & 7, dv = (hsh >> 12) & 127;
        float* Scol = scr + (size_t)(gt - 512 + 64) * 128;
        naive_gdn_col(F, (size_t)b * SEQ, SEQ, nullptr, nullptr, h, dv, Scol, 9, true);
        for (int dk = 0; dk < 128; ++dk) chk_put(F, 9, F.out[O_GSP + ((size_t)(b * 8 + h) * 128 + dk) * 128 + dv], Scol[dk], 1e-3f);
    }
}
__device__ __forceinline__ void debug_report(Frame& F) {
    const size_t osz[10] = {(size_t)MP * D, (size_t)MS * D, (size_t)MMEM * D, (size_t)MMEM * D, (size_t)NB * 3 * 3072, (size_t)NB * NH * DK * DK, (size_t)NB * 2 * D, (size_t)DB * 3 * 3072, (size_t)DB * NH * DK * DK, (size_t)DB * 2 * D};
    const size_t gt = (size_t)F.vcu * (NWAVES * 64) + F.tid, NT = (size_t)F.G * NWAVES * 64; size_t off = 0;
    for (int c = 0; c < 10; ++c) {
        const float num = __uint_as_float(__hip_atomic_load(F.ctl + CW_CHK + 2 * c, RLX_AGENT)), den = __uint_as_float(__hip_atomic_load(F.ctl + CW_CHK + 2 * c + 1, RLX_AGENT));
        int cnt = (den <= 0.f) ? 99 : (num <= 0.f) ? 98 : (int)(10.f - 10.f * log10f(num / den) + 0.5f); cnt = cnt < 10 ? 10 : (cnt > 97 ? 97 : cnt);
        for (size_t i = gt; i < osz[c]; i += NT) F.out[off + i] = (i < (size_t)cnt) ? __uint_as_float(0xAAAAAAAAu) : 1.0f;
        off += osz[c];
    }
}
#endif

constexpr int PH_P2C = 4 + MK_DEBUG, PH_P3 = PH_P2C + 1, PH_P4 = PH_P3 + 1, PH_P5 = PH_P4 + 1, PH_P6 = PH_P5 + 1, PH_P7 = PH_P6 + 1, PH_P8 = PH_P7 + 1, PH_P9 = PH_P8 + 1, PH_P10 = PH_P9 + 1, PH_LAST = PH_P10;
constexpr int N_PHASES = PH_LAST + 1 + 2 * MK_DEBUG;
__global__ void __launch_bounds__(NWAVES * 64, 2) mk_fwd(Args args) {
    extern __shared__ __attribute__((aligned(16))) unsigned char lds[];
    Frame F;
    F.lds = (LAS unsigned char*)lds;
    F.MISC = (volatile LAS unsigned*)(F.lds + MISC_OFF);
    F.tid = threadIdx.x; F.lane = F.tid & 63; F.wave = __builtin_amdgcn_readfirstlane(F.tid >> 6);
    F.G = gridDim.x; { const int bx = blockIdx.x; F.vcu = (F.G % 8 == 0) ? (bx % 8) * (F.G / 8) + bx / 8 : bx; }
    F.in = args.in; F.out = args.out; F.ws = args.ws;
    F.ctl = (gu32*)(args.ws + WS_CTL);
    for (int u = F.tid; u < (LDS_BYTES - LDSCTL_OFF) / 4; u += NWAVES * 64) ((LAS unsigned*)(F.lds + LDSCTL_OFF))[u] = 0u;
    __syncthreads();
    XcdBarrier bar = xcd_barrier_post((unsigned*)(F.ctl + CW_BAR) + args.li * XCD_BAR_WORDS, F.MISC + 8);
    const int lo = args.ph_lo, hi = args.ph_hi;
#define IN(k) (lo <= (k) && (k) < hi)
#define BOTH(k) (IN(k) && IN((k) + 1))
#define GRID_BAR() xcd_barrier(bar)
#if MK_TIMING
    int n_stamp = 0;
#define STAMP() do { if (blockIdx.x == 0 && F.tid == 0) __hip_atomic_store(F.ctl + 1024 + 2 * n_stamp, (unsigned)(__builtin_amdgcn_s_memrealtime()), RLX_AGENT); ++n_stamp; } while (0)
#define SUBSTAMP(k) do { if (blockIdx.x == 0 && F.tid == 0) __hip_atomic_store(F.ctl + 1024 + 2 * (20 + (k)), (unsigned)(__builtin_amdgcn_s_memrealtime()), RLX_AGENT); } while (0)
#else
#define STAMP() do {} while (0)
#define SUBSTAMP(k) do {} while (0)
#endif
    STAMP();
    unsigned char* ws = args.ws;

    if (IN(0)) { p0_prologue(F); if (BOTH(0)) GRID_BAR(); STAMP(); }

    if (IN(1)) {
        LAS unsigned* tab = (LAS unsigned*)(F.lds + TAB_OFF);
        if (F.tid == 0) {
            tab[0] = (unsigned)WS_XN; tab[4] = (unsigned)WS_WIN; tab[8] = M / 256; tab[12] = NIN_T / 256;
            tab[1] = (unsigned)WS_MN; tab[5] = (unsigned)WS_WXKV; tab[9] = MMEM / 256; tab[13] = 8;
            tab[2] = (unsigned)(WS_WXKV + (size_t)D * D * 2); tab[6] = (unsigned)WS_MN; tab[10] = D / 256; tab[14] = MMEM / 256; }
        __syncthreads();
        pg8::Probs P{ws, tab, 3, D};
        pg8::GroupOrder S; S.init(P, F.G, (int)blockIdx.x);
        EpiP1 E{ws, F.out};
        pg8::gemm_phase<EpiP1, pg8::GroupOrder>(F.lds + RING_OFF, P, S, E);
        if (BOTH(1)) GRID_BAR(); STAMP();
    }

    if (IN(2)) {
        SUBSTAMP(0);
        for (int pu = F.vcu; pu < NB * NH * 16; pu += F.G) gdn_prep_unit(F, pu);
        SUBSTAMP(1);
        for (int su = F.vcu; su < DB * NH / 4; su += F.G) gdn_sample_unit(F, su);
        SUBSTAMP(2);
        sc_conv_pass(F);
        SUBSTAMP(3);
        copy_conv_states(F);
        SUBSTAMP(4);
        if (BOTH(2)) GRID_BAR(); STAMP();
    }
    if (IN(3)) {
        for (int bh = F.vcu; bh < NB * NH; bh += F.G) gdn_scan_unit(F, bh);
        if (BOTH(3)) GRID_BAR(); STAMP();
    }
#if MK_DEBUG
    if (IN(4)) { debug_checks_gdn(F); }
#endif
    if (IN(PH_P2C)) { og_pass(F); if (BOTH(PH_P2C)) GRID_BAR(); STAMP(); }
    LAS unsigned* tab = (LAS unsigned*)(F.lds + TAB_OFF);
    float* const ssq = (float*)(ws + WS_SSQ);
#define SET_TAB1(oa, ob, nm, nn) do { __syncthreads(); if (F.tid == 0) { tab[0] = (unsigned)(oa); tab[4] = (unsigned)(ob); tab[8] = (nm); tab[12] = (nn); } __syncthreads(); } while (0)
    if (IN(PH_P3)) {
        __syncthreads();
        if (F.tid == 0) { tab[0] = (unsigned)((size_t)((unsigned char*)(F.out + O_Y) - ws) + (size_t)M * D * 2); tab[4] = (unsigned)WS_WSCO; tab[8] = M / 256; tab[12] = 4; tab[1] = (unsigned)WS_O; tab[5] = (unsigned)WS_WGDNO; tab[9] = M / 256; tab[13] = 4; }
        __syncthreads();
        pg8::Probs P{ws, tab, 2, D}; pg8::PairOrder S; S.init(P, F.G, (int)blockIdx.x);
        EpiP3 E{ws};
        pg8::gemm_phase<EpiP3, pg8::PairOrder>(F.lds + RING_OFF, P, S, E);
        if (BOTH(PH_P3)) GRID_BAR(); STAMP();
    }
    if (IN(PH_P4)) {
        SET_TAB1(WS_MG, WS_WMIX, M / 256, 4);
        pg8::Probs P{ws, tab, 1, D}; pg8::GroupOrder S; S.init(P, F.G, (int)blockIdx.x);
        EpiRes<true> E{F.in[I_XP], F.in[I_XS], F.out + O_Y, F.in[I_NX], (bf16*)(ws + WS_XN), ssq, true};
        pg8::gemm_phase<EpiRes<true>, pg8::GroupOrder>(F.lds + RING_OFF, P, S, E);
        if (BOTH(PH_P4)) GRID_BAR(); STAMP();
    }
    if (IN(PH_P5)) {
        SET_TAB1(WS_XN, WS_WXQ, M / 256, 4);
        pg8::Probs P{ws, tab, 1, D}; pg8::GroupOrder S; S.init(P, F.G, (int)blockIdx.x);
        EpiScale<0> E{ssq, (bf16*)(ws + WS_Q), D, 0.0625f};
        pg8::gemm_phase<EpiScale<0>, pg8::GroupOrder>(F.lds + RING_OFF, P, S, E);
        if (BOTH(PH_P5)) GRID_BAR(); STAMP();
    }
    if (IN(PH_P6)) {
        for (int u = F.vcu; u < NB * XH * 8; u += F.G) attn_prompt_unit(F, u);
        for (int bp = F.vcu; bp < DB * XH / 2; bp += F.G) attn_sample_pass(F, bp);
        if (BOTH(PH_P6)) GRID_BAR(); STAMP();
    }
    if (IN(PH_P7)) {
        SET_TAB1(WS_CTX, WS_WXO, M / 256, 4);
        pg8::Probs P{ws, tab, 1, D}; pg8::GroupOrder S; S.init(P, F.G, (int)blockIdx.x);
        EpiRes<false> E{nullptr, nullptr, F.out + O_Y, F.in[I_NMLP], (bf16*)(ws + WS_XN), ssq + (size_t)M * 16, true};
        pg8::gemm_phase<EpiRes<false>, pg8::GroupOrder>(F.lds + RING_OFF, P, S, E);
        if (BOTH(PH_P7)) GRID_BAR(); STAMP();
    }
    if (IN(PH_P8)) {
        SET_TAB1(WS_XN, WS_WUP, M / 256, FF / 256);
        pg8::Probs P{ws, tab, 1, D}; pg8::GroupOrder S; S.init(P, F.G, (int)blockIdx.x);
        EpiScale<1> E{ssq + (size_t)M * 16, (bf16*)(ws + WS_HB), FF, 1.f};
        pg8::gemm_phase<EpiScale<1>, pg8::GroupOrder>(F.lds + RING_OFF, P, S, E);
        if (BOTH(PH_P8)) GRID_BAR(); STAMP();
    }
    if (IN(PH_P9)) {
        SET_TAB1(WS_HB, WS_WDN, M / 256, 4);
        pg8::Probs P{ws, tab, 1, FF}; pg8::GroupOrder S; S.init(P, F.G, (int)blockIdx.x);
        EpiRes<false> E{nullptr, nullptr, F.out + O_Y, F.in[I_NF], nullptr, ssq + 2 * (size_t)M * 16, false};
        pg8::gemm_phase<EpiRes<false>, pg8::GroupOrder>(F.lds + RING_OFF, P, S, E);
        if (BOTH(PH_P9)) GRID_BAR(); STAMP();
    }
    if (IN(PH_P10)) { final_norm_pass(F); }
#if MK_TIMING
    GRID_BAR(); STAMP();
    {
        const size_t osz[10] = {(size_t)MP * D, (size_t)MS * D, (size_t)MMEM * D, (size_t)MMEM * D, (size_t)NB * 3 * 3072, (size_t)NB * NH * DK * DK, (size_t)NB * 2 * D, (size_t)DB * 3 * 3072, (size_t)DB * NH * DK * DK, (size_t)DB * 2 * D};
#if MK_TIMING == 1
        const int s0[10] = {0, 1, 2, 3, 4, 5, 6, 8, 9, 11}, s1[10] = {1, 2, 3, 4, 5, 6, 8, 9, 11, 13};
#else
        const int s0[10] = {25, 26, 27, 28, 29, 25, 9, 10, 11, 12}, s1[10] = {26, 27, 28, 29, 30, 30, 10, 11, 12, 13};
#endif
        const size_t gt = (size_t)F.vcu * (NWAVES * 64) + F.tid, NT = (size_t)F.G * NWAVES * 64; size_t off = 0;
        for (int c = 0; c < 10; ++c) {
            const unsigned t0 = __hip_atomic_load(F.ctl + 1024 + 2 * s0[c], RLX_AGENT), t1 = __hip_atomic_load(F.ctl + 1024 + 2 * s1[c], RLX_AGENT);
            int cnt = (c < 6 && MK_TIMING == 2) ? (int)((t1 - t0) / 10u) : (int)((t1 - t0) / 100u); cnt = cnt < 1 ? 1 : cnt;
            for (size_t i = gt; i < osz[c]; i += NT) F.out[off + i] = (i < (size_t)cnt) ? __uint_as_float(0xAAAAAAAAu) : 1.0f;
            off += osz[c];
        }
    }
#endif
#if MK_DEBUG
    if (IN(N_PHASES - 2)) { debug_checks(F); if (BOTH(N_PHASES - 2)) GRID_BAR(); }
    if (IN(N_PHASES - 1)) { debug_report(F); }
#endif
#undef IN
#undef BOTH
}

#ifndef MK_ONE_LAUNCH
#define MK_ONE_LAUNCH 1
#endif
extern "C" void kernel_launch(void* const* d_in, const int* in_sizes, int n_in, void* d_out, int out_size, void* d_ws, size_t ws_size, hipStream_t stream) {
    static int grid = 0;
    if (grid == 0) {
        if (n_in != 27 || out_size != (int)O_END || ws_size < WS_END) { fprintf(stderr, "kernel_launch: unexpected shapes: n_in %d out %d ws %zu (need %zu)\n", n_in, out_size, ws_size, (size_t)WS_END); grid = -1; return; }
        int dev = 0, cus = 0;
        if (hipGetDevice(&dev) != hipSuccess || hipDeviceGetAttribute(&cus, hipDeviceAttributeMultiprocessorCount, dev) != hipSuccess) { grid = -1; return; }
        if (hipFuncSetAttribute((const void*)mk_fwd, hipFuncAttributeMaxDynamicSharedMemorySize, LDS_BYTES) != hipSuccess) { fprintf(stderr, "kernel_launch: hipFuncSetAttribute failed\n"); grid = -1; return; }
        int per_cu = 0;
        (void)hipOccupancyMaxActiveBlocksPerMultiprocessor(&per_cu, (const void*)mk_fwd, NWAVES * 64, LDS_BYTES);
        (void)hipGetLastError();
        grid = cus;
    }
    if (grid < 0) return;
    (void)hipMemsetAsync((char*)d_ws + WS_CTL, 0, CTL_ZERO_BYTES, stream);
    Args a{};
    for (int i = 0; i < 27; ++i) a.in[i] = (const float*)d_in[i];
    a.out = (float*)d_out; a.ws = (unsigned char*)d_ws;
#if MK_ONE_LAUNCH
    a.ph_lo = 0; a.ph_hi = N_PHASES; a.li = 0;
    hipLaunchKernelGGL(mk_fwd, dim3(grid), dim3(NWAVES * 64), LDS_BYTES, stream, a);
#else
    for (int p = 0; p < N_PHASES; ++p) { a.ph_lo = p; a.ph_hi = p + 1; a.li = p;
        hipLaunchKernelGGL(mk_fwd, dim3(grid), dim3(NWAVES * 64), LDS_BYTES, stream, a); }
#endif
}
```

```cpp
#include <hip/hip_runtime.h>
#include <cstdio>
#include <cstdint>
#include <cmath>
#ifndef MK_DEBUG
#define MK_DEBUG 0
#endif
#ifndef MK_TIMING
#define MK_TIMING 0
#endif
#ifndef MK_EXP
#define MK_EXP 0
#endif

namespace pg8 {
#define PG8_LAS __attribute__((address_space(3)))
typedef unsigned short bf16_t;
typedef short bf16x8 __attribute__((ext_vector_type(8)));
typedef float f32x4 __attribute__((ext_vector_type(4)));
typedef unsigned u32x4 __attribute__((ext_vector_type(4)));
typedef unsigned u32x2 __attribute__((ext_vector_type(2)));
constexpr int BM = 256, BK = 64, HALF = 128, HTB = HALF * BK * 2, STAGE_BYTES = 8 * HTB, NXCD = 8, WGM = 8;

__host__ __device__ __forceinline__ int lds_byte(int r, int c) { const int st = (r >> 4) * 2 + (c >> 5), rr = r & 15, cc = c & 31, ob = rr * 64 + cc * 2; return st * 1024 + (ob ^ (((ob >> 9) & 1) << 5)); }
__host__ __device__ __forceinline__ void stage_rc(int b, int& R, int& C) { const int st = b / 1024, sb = b % 1024, swz = sb ^ (((sb >> 9) & 1) << 5); R = (st >> 1) * 16 + swz / 64; C = (st & 1) * 32 + (swz % 64) / 2; }
__host__ __device__ __forceinline__ int perm32(int rho) { const int n = rho >> 4, i = rho & 15; return 8 * (i >> 2) + 4 * n + (i & 3); }

struct Unit { int pm, pn, g; };
constexpr int MAXG = 4;
struct Probs { const unsigned char* base; PG8_LAS const unsigned* tab; int ng; int K; };
__device__ __forceinline__ int tabv(PG8_LAS const unsigned* tab, int i) { return __builtin_amdgcn_readfirstlane((int)tab[i]); }

struct GroupOrder {
    PG8_LAS const unsigned* tab; int ng, G, c;
    __device__ __forceinline__ void init(const Probs& P, int G_, int c_) { tab = P.tab; ng = P.ng; G = G_; c = c_; }
    __device__ __forceinline__ bool next(int i, Unit& u) const {
        int L = i * G + c; int g = -1, nm = 1, nn = 1, nwg = 1;
        for (int p = 0; p < ng; ++p) { const int a = tabv(tab, 8 + p), b = tabv(tab, 12 + p); if (L < a * b) { g = p; nm = a; nn = b; nwg = a * b; break; } L -= a * b; }
        if (g < 0) return false;
        int wgid = L; { const int q = nwg / NXCD, r = nwg % NXCD, xcd = wgid % NXCD, off = wgid / NXCD; wgid = (xcd < r ? xcd * (q + 1) : r * (q + 1) + (xcd - r) * q) + off; }
        const int nig = WGM * nn, gid = wgid / nig, fm = gid * WGM, gsz = (nm - fm) < WGM ? (nm - fm) : WGM;
        u.pm = fm + ((wgid % nig) % gsz); u.pn = (wgid % nig) / gsz; u.g = g; return true;
    }
};

__device__ __forceinline__ unsigned cvt_pk_bf16(float lo, float hi) { unsigned r; asm volatile("v_cvt_pk_bf16_f32 %0, %1, %2" : "=v"(r) : "v"(lo), "v"(hi)); return r; }

struct PairOrder {
    PG8_LAS const unsigned* tab; int ng, G, c;
    __device__ __forceinline__ void init(const Probs& P, int G_, int c_) { tab = P.tab; ng = P.ng; G = G_; c = c_; }
    __device__ __forceinline__ bool next(int i, Unit& u) const {
        const int nm = tabv(tab, 8), nn = tabv(tab, 12), nwg = nm * nn; const int L = (i >> 1) * G + c; if (L >= nwg) return false;
        int wgid = L; { const int q = nwg / NXCD, r = nwg % NXCD, xcd = wgid % NXCD, off = wgid / NXCD; wgid = (xcd < r ? xcd * (q + 1) : r * (q + 1) + (xcd - r) * q) + off; }
        const int nig = WGM * nn, gid = wgid / nig, fm = gid * WGM, gsz = (nm - fm) < WGM ? (nm - fm) : WGM;
        u.pm = fm + ((wgid % nig) % gsz); u.pn = (wgid % nig) / gsz; u.g = i & 1; return true;
    }
};

template <class Epi, class Sched>
__device__ __forceinline__ void gemm_phase(PG8_LAS unsigned char* lds, const Probs& P, const Sched& S, const Epi& E) {
    const int tid = threadIdx.x, wid = __builtin_amdgcn_readfirstlane(tid >> 6), lane = tid & 63, wr = wid >> 2, wc = wid & 3, fr = lane & 15, fq = lane >> 4;
    const int K = P.K, nt = K / BK;
    unsigned voffA[2], voffB[2];
#pragma unroll
    for (int i = 0; i < 2; ++i) { int R, C; stage_rc(tid * 16 + i * 8192, R, C); const int Rb = (R & ~31) + perm32(R & 31);
        voffA[i] = (unsigned)(R * K + C) * 2u; voffB[i] = (unsigned)(Rb * K + C) * 2u; }
    const size_t kstep = (size_t)(BK * 2);
    const size_t hstep = (size_t)HALF * K * 2;
    const size_t tstep = 2 * hstep;
    const unsigned ldsw = (unsigned)wid * 1024u;
    const int aoff = lds_byte(wr * 64 + fr, fq * 8), boff = lds_byte(wc * 32 + fr, fq * 8);
#define PG8_SA(b, h) (((b) * 2 + (h)) * HTB)
#define PG8_SB(b, h) ((4 + (b) * 2 + (h)) * HTB)
#define PG8_STAGE(bufoff, gbase, voff) do { _Pragma("unroll") for (int _i = 0; _i < 2; ++_i) \
        __builtin_amdgcn_global_load_lds((const unsigned*)((const char*)(gbase) + (voff)[_i]), (PG8_LAS unsigned*)(lds + (bufoff) + ldsw + _i * 8192), 16, 0, 0); } while (0)
#define PG8_LDA(dst, b, h) do { _Pragma("unroll") for (int m = 0; m < 4; ++m) _Pragma("unroll") for (int k = 0; k < 2; ++k) dst[m][k] = *(const PG8_LAS bf16x8*)(lds + PG8_SA(b, h) + aoff + m * 2048 + k * 1024); } while (0)
#define PG8_LDB(dst, b, h) do { _Pragma("unroll") for (int n = 0; n < 2; ++n) _Pragma("unroll") for (int k = 0; k < 2; ++k) dst[n][k] = *(const PG8_LAS bf16x8*)(lds + PG8_SB(b, h) + boff + n * 2048 + k * 1024); } while (0)
#define PG8_MMA(ai, bj, At, Bt) do { __builtin_amdgcn_s_setprio(1); _Pragma("unroll") for (int m = 0; m < 4; ++m) _Pragma("unroll") for (int n = 0; n < 2; ++n) _Pragma("unroll") for (int k = 0; k < 2; ++k) \
        acc[ai][bj][m][n] = __builtin_amdgcn_mfma_f32_16x16x32_bf16(Bt[n][k], At[m][k], acc[ai][bj][m][n], 0, 0, 0); __builtin_amdgcn_s_setprio(0); } while (0)
#define PG8_WAIT_V(n) asm volatile("s_waitcnt vmcnt(" #n ")" ::: "memory")
#define PG8_WAIT_L(n) asm volatile("s_waitcnt lgkmcnt(" #n ")" ::: "memory")
#define PG8_BAR __builtin_amdgcn_s_barrier()
#define PG8_SCHED __builtin_amdgcn_sched_barrier(0)
#define PG8_PA(u) ((const char*)P.base + (long long)(((unsigned long long)(unsigned)tabv(P.tab, 16 + (u).g) << 32) | (unsigned long long)(unsigned)tabv(P.tab, (u).g)) + (size_t)(u).pm * tstep)
#define PG8_PB(u) ((const char*)P.base + (unsigned)tabv(P.tab, 4 + (u).g) + (size_t)(u).pn * tstep)
    Unit cur, nxt; int ui = 0;
    if (!S.next(0, cur)) return;
    f32x4 acc[2][2][4][2];
#pragma unroll
    for (int a = 0; a < 2; ++a)
#pragma unroll
        for (int b = 0; b < 2; ++b)
#pragma unroll
            for (int m = 0; m < 4; ++m)
#pragma unroll
                for (int n = 0; n < 2; ++n) acc[a][b][m][n] = (f32x4){0.f, 0.f, 0.f, 0.f};
    bf16x8 At[4][2], B0[2][2], B1[2][2];
    const char* cA = PG8_PA(cur); const char* cB = PG8_PB(cur);
    PG8_STAGE(PG8_SB(0, 0), cB, voffB); PG8_STAGE(PG8_SB(0, 1), cB + hstep, voffB); PG8_STAGE(PG8_SA(0, 0), cA, voffA); PG8_STAGE(PG8_SA(0, 1), cA + hstep, voffA);
    if (wr == 1) PG8_BAR;
    PG8_WAIT_V(2); PG8_BAR;
    PG8_STAGE(PG8_SB(1, 0), cB + kstep, voffB); PG8_STAGE(PG8_SA(1, 0), cA + kstep, voffA); PG8_STAGE(PG8_SB(1, 1), cB + hstep + kstep, voffB);
    PG8_WAIT_V(6); PG8_BAR;
    for (;;) {
        const bool has_next = S.next(ui + 1, nxt);
        const char* nA = cA; const char* nB = cB;
        if (has_next) { nA = PG8_PA(nxt); nB = PG8_PB(nxt); }
        for (int t = 0; t < nt; t += 2) {
            const bool last = (t == nt - 2);
            const char* a1 = cA + (size_t)(t + 1) * kstep;
            const char* a2 = last ? nA : cA + (size_t)(t + 2) * kstep; const char* b2 = last ? nB : cB + (size_t)(t + 2) * kstep;
            const char* a3 = a2 + kstep; const char* b3 = b2 + kstep;
            PG8_LDB(B0, 0, 0); PG8_LDB(B1, 0, 1); PG8_SCHED; PG8_LDA(At, 0, 0); PG8_STAGE(PG8_SA(1, 1), a1 + hstep, voffA);
            PG8_WAIT_V(8); PG8_WAIT_L(0); PG8_BAR; PG8_MMA(0, 0, At, B0); PG8_MMA(0, 1, At, B1); PG8_BAR; PG8_SCHED;
            PG8_LDA(At, 0, 1); PG8_STAGE(PG8_SB(0, 0), b2, voffB); PG8_STAGE(PG8_SB(0, 1), b2 + hstep, voffB); PG8_STAGE(PG8_SA(0, 0), a2, voffA);
            PG8_WAIT_V(8); PG8_WAIT_L(0); PG8_BAR; PG8_MMA(1, 0, At, B0); PG8_MMA(1, 1, At, B1); PG8_BAR; PG8_SCHED;
            PG8_LDB(B0, 1, 0); PG8_LDB(B1, 1, 1); PG8_SCHED; PG8_LDA(At, 1, 0); PG8_STAGE(PG8_SA(0, 1), a2 + hstep, voffA);
            PG8_WAIT_V(8); PG8_WAIT_L(0); PG8_BAR; PG8_MMA(0, 0, At, B0); PG8_MMA(0, 1, At, B1); PG8_BAR; PG8_SCHED;
            PG8_LDA(At, 1, 1); PG8_STAGE(PG8_SB(1, 0), b3, voffB); PG8_STAGE(PG8_SB(1, 1), b3 + hstep, voffB); PG8_STAGE(PG8_SA(1, 0), a3, voffA);
            PG8_WAIT_V(8); PG8_WAIT_L(0); PG8_BAR; PG8_MMA(1, 0, At, B0); PG8_MMA(1, 1, At, B1); PG8_BAR; PG8_SCHED;
        }
        if (wr == 0) PG8_BAR;
        E(acc, cur, wr, wc, fr, fq);
        if (!has_next) break;
#pragma unroll
        for (int a = 0; a < 2; ++a)
#pragma unroll
            for (int b = 0; b < 2; ++b)
#pragma unroll
                for (int m = 0; m < 4; ++m)
#pragma unroll
                    for (int n = 0; n < 2; ++n) acc[a][b][m][n] = (f32x4){0.f, 0.f, 0.f, 0.f};
        cur = nxt; cA = nA; cB = nB; ++ui;
        if (wr == 1) PG8_BAR;
    }
    PG8_WAIT_V(0);
    PG8_BAR;
#undef PG8_SA
#undef PG8_SB
#undef PG8_STAGE
#undef PG8_LDA
#undef PG8_LDB
#undef PG8_MMA
#undef PG8_WAIT_V
#undef PG8_WAIT_L
#undef PG8_BAR
#undef PG8_SCHED
#undef PG8_PA
#undef PG8_PB
}
}

constexpr int NWAVES = 8;
constexpr int D = 1024, NB = 8, SEQ = 2048, MP = NB * SEQ, DB = 128, DS = 8, MS = DB * DS, M = MP + MS;
constexpr int NH = 8, DK = 128, NMEM = 256, XH = 4, XD = 256, FF = 4096, NIN = 9232, NIN_T = 9216, MMEM = NB * NMEM;
constexpr float EPS = 1e-6f;
constexpr size_t O_Y = 0, O_MK = (size_t)M * D, O_MV = O_MK + (size_t)MMEM * D, O_GCP = O_MV + (size_t)MMEM * D, O_GSP = O_GCP + (size_t)NB * 3 * 3072,
                 O_SCP = O_GSP + (size_t)NB * NH * DK * DK, O_GCS = O_SCP + (size_t)NB * 2 * D, O_GSS = O_GCS + (size_t)DB * 3 * 3072, O_SCS = O_GSS + (size_t)DB * NH * DK * DK,
                 O_END = O_SCS + (size_t)DB * 2 * D;
static_assert(O_END == 41377792, "output size");

constexpr size_t MiB = 1u << 20;
constexpr size_t WS_CTL = 0, CTL_ZERO_BYTES = 1 * MiB;
constexpr size_t WS_WIN = 1 * MiB;
constexpr size_t WS_WGDNO = 19 * MiB, WS_WSCO = 21 * MiB, WS_WMIX = 23 * MiB, WS_WXQ = 25 * MiB, WS_WXO = 27 * MiB;
constexpr size_t WS_WXKV = 29 * MiB;
constexpr size_t WS_WUP = 33 * MiB;
constexpr size_t WS_WDN = 41 * MiB;
constexpr size_t WS_XN = 49 * MiB;
constexpr size_t WS_MN = 83 * MiB;
constexpr size_t WS_AB = 87 * MiB;
constexpr size_t WS_KB = 89 * MiB;
constexpr size_t WS_VT = 93 * MiB;
constexpr size_t WS_QKV = 97 * MiB;
constexpr size_t WS_UPRE = 199 * MiB, WS_SGA = 233 * MiB, WS_SGB = 267 * MiB;
constexpr size_t WS_R3 = 301 * MiB;
constexpr size_t WS_END = 445 * MiB;
constexpr size_t WS_YB = WS_QKV, WS_Q = WS_QKV, WS_MG = WS_R3, WS_CTX = WS_R3, WS_HB = WS_QKV;
constexpr size_t WS_SSQ = WS_SGA;
constexpr int CW_TMO = 0, CW_BAR = 4096;

#define GAS __attribute__((address_space(1)))
#define LAS __attribute__((address_space(3)))
typedef unsigned short bf16;
typedef unsigned v4u __attribute__((ext_vector_type(4)));
typedef unsigned v2u __attribute__((ext_vector_type(2)));
typedef float f32x4 __attribute__((ext_vector_type(4)));
typedef float f32x2 __attribute__((ext_vector_type(2)));
typedef short bf16x8 __attribute__((ext_vector_type(8)));
typedef __bf16 bf16x2_t __attribute__((ext_vector_type(2)));
typedef GAS unsigned gu32;
#define RLX_AGENT __ATOMIC_RELAXED, __HIP_MEMORY_SCOPE_AGENT
#define LDS_WAIT() asm volatile("s_waitcnt lgkmcnt(0)" ::: "memory")
#define VM_WAIT() asm volatile("s_waitcnt vmcnt(0)" ::: "memory")
__device__ __forceinline__ unsigned pk2(float lo, float hi) { f32x2 v = {lo, hi}; bf16x2_t b = __builtin_convertvector(v, bf16x2_t); return __builtin_bit_cast(unsigned, b); }
__device__ __forceinline__ float bf2f(unsigned short h) { return __uint_as_float((unsigned)h << 16); }
__device__ __forceinline__ float bflo(unsigned u) { return __uint_as_float(u << 16); }
__device__ __forceinline__ float bfhi(unsigned u) { return __uint_as_float(u & 0xffff0000u); }
__device__ __forceinline__ float sigmoidf_(float x) { return __builtin_amdgcn_rcpf(1.f + __builtin_amdgcn_exp2f(-1.4426950408889634f * x)); }
__device__ __forceinline__ float siluf_(float x) { return x * __builtin_amdgcn_rcpf(1.f + __builtin_amdgcn_exp2f(-1.4426950408889634f * x)); }
__device__ __forceinline__ float rsqf_(float x) { return __builtin_amdgcn_rsqf(x); }
template <int CTRL> __device__ __forceinline__ float dpp_f(float v) { return __builtin_bit_cast(float, __builtin_amdgcn_update_dpp(0, __builtin_bit_cast(int, v), CTRL, 0xf, 0xf, true)); }
__device__ __forceinline__ float half_sum(float v) { v += dpp_f<0xB1>(v); v += dpp_f<0x4E>(v); v += dpp_f<0x124>(v); v += dpp_f<0x128>(v); v += __shfl_xor(v, 16); return v; }

#define XB_TMO      128
#define XB_XCNT(j)  (256  + 64 * (j))
#define XB_XSUB(j)  (1280 + 64 * (j))
#define XB_XGEN(j)  (2304 + 64 * (j))
#define XB_TOP      3328
#define XB_TOPGEN   3392
#define XCD_BAR_WORDS 3456
#define XB_SPIN_CAP (1u << 18)
__device__ __forceinline__ unsigned xb_ld(unsigned* p)              { return __hip_atomic_load(p, __ATOMIC_RELAXED, __HIP_MEMORY_SCOPE_AGENT); }
__device__ __forceinline__ unsigned xb_add(unsigned* p, unsigned v) { return __hip_atomic_fetch_add(p, v, __ATOMIC_RELAXED, __HIP_MEMORY_SCOPE_AGENT); }
__device__ __forceinline__ unsigned xb_xcc_id() { return (unsigned)__builtin_amdgcn_s_getreg((3 << 11) | 20) & 0xFu; }
#define XB_SPIN(cond, bar) do { unsigned _sp = 0; while (cond) { __builtin_amdgcn_s_sleep(1); \
    if ((++_sp & 255u) == 0u) { if (xb_ld(&(bar)[XB_TMO])) break; if (_sp > XB_SPIN_CAP) { atomicAdd(&(bar)[XB_TMO], 1u); break; } } } } while (0)
struct XcdBarrier { unsigned* bar; unsigned x; volatile LAS unsigned* st; };
__device__ __forceinline__ XcdBarrier xcd_barrier_post(unsigned* bar, volatile LAS unsigned* st) {
    XcdBarrier b; b.bar = bar; b.x = xb_xcc_id(); b.st = st;
    if (threadIdx.x == 0) (void)xb_add(&bar[XB_XCNT(b.x)], 1u);
    return b;
}
__device__ __forceinline__ void xcd_barrier_complete(unsigned* bar, unsigned x, unsigned& nloc, unsigned& nx) {
    const unsigned G = gridDim.x * gridDim.y * gridDim.z;
    unsigned sum, cnt, mine, sp = 0u;
    for (;;) {
        sum = 0u; cnt = 0u; mine = 0u;
#pragma unroll
        for (unsigned j = 0; j < 16; ++j) { const unsigned c = xb_ld(&bar[XB_XCNT(j)]); sum += c; cnt += (c > 0u) ? 1u : 0u; mine = (j == x) ? c : mine; }
        if (sum == G) break;
        __builtin_amdgcn_s_sleep(1);
        if ((++sp & 255u) == 0u) { if (xb_ld(&bar[XB_TMO])) break; if (sp > XB_SPIN_CAP) { atomicAdd(&bar[XB_TMO], 1u); break; } }
    }
    nloc = mine > 0u ? mine : 1u; nx = cnt > 0u ? cnt : 1u;
}
__device__ __forceinline__ void xcd_barrier(const XcdBarrier& b) {
    asm volatile("s_waitcnt vmcnt(0)" ::: "memory");
    __syncthreads();
    if (threadIdx.x == 0) {
        unsigned* bar = b.bar;
        __builtin_amdgcn_s_waitcnt(0);
        unsigned nloc = b.st[0], nx = b.st[1];
        if (nloc == 0u) { xcd_barrier_complete(bar, b.x, nloc, nx); b.st[0] = nloc; b.st[1] = nx; }
        const unsigned old = xb_add(&bar[XB_XSUB(b.x)], 1u);
        const unsigned gen = old / nloc;
        if (old + 1u == (gen + 1u) * nloc) {
            __builtin_amdgcn_fence(__ATOMIC_RELEASE, "agent");
            asm volatile("s_waitcnt vmcnt(0)" ::: "memory");
            const unsigned og = xb_add(&bar[XB_TOP], 1u);
            const unsigned tg = og / nx;
            if (og + 1u == (tg + 1u) * nx) xb_add(&bar[XB_TOPGEN], 1u);
            else XB_SPIN(xb_ld(&bar[XB_TOPGEN]) == tg, bar);
            __builtin_amdgcn_fence(__ATOMIC_ACQUIRE, "agent");
            xb_add(&bar[XB_XGEN(b.x)], 1u);
            asm volatile("s_waitcnt vmcnt(0)" ::: "memory");
        } else {
            XB_SPIN(xb_ld(&bar[XB_XGEN(b.x)]) == gen, bar);
            __builtin_amdgcn_fence(__ATOMIC_ACQUIRE, "agent");
            asm volatile("s_waitcnt vmcnt(0)" ::: "memory");
        }
    }
    __syncthreads();
}

constexpr int RING_OFF = 0, RING_BYTES = 131072;
constexpr int LDSCTL_OFF = 147456, MISC_OFF = LDSCTL_OFF + 320, TAB_OFF = LDSCTL_OFF + 64;
constexpr int LDS_BYTES = 163840;

struct Args {
    const float* in[27]; float* out; unsigned char* ws; int ph_lo, ph_hi, li, pad;
};
enum { I_XP = 0, I_XS, I_MEM, I_CK, I_CV, I_SGC, I_SG, I_SSC, I_NMIX, I_WIN, I_GCW, I_ALOG, I_DTB, I_GON, I_WGDNO, I_SCW, I_WSCO, I_WMIX, I_NX, I_NMEM, I_WXQ, I_WXKV, I_WXO, I_NMLP, I_WUP, I_WDN, I_NF };

struct Frame {
    LAS unsigned char* lds; volatile LAS unsigned* MISC; gu32* ctl;
    int tid, lane, wave, vcu, G;
    const float* const* in; float* out; unsigned char* ws;
};
__device__ __forceinline__ float wave_sum(float v) {
#pragma unroll
    for (int o = 1; o < 64; o <<= 1) v += __shfl_xor(v, o);
    return v;
}

__device__ __forceinline__ void p0_transpose_block(const float* W, int ldw, int K, int k0, int src_col, bf16* WT, int dst_row, LAS float* scr, int lane) {
#pragma unroll 8
    for (int i = 0; i < 32; ++i) { const int kk = 2 * i + (lane >> 5); scr[kk * 33 + (lane & 31)] = W[(size_t)(k0 + kk) * ldw + src_col + (lane & 31)]; }
    LDS_WAIT(); asm volatile("" ::: "memory");
    const int c = lane & 7;
#pragma unroll
    for (int j = 0; j < 4; ++j) { const int n = (lane >> 3) + 8 * j; const LAS float* s = scr + (8 * c) * 33 + n;
        v4u o; o.x = pk2(s[0 * 33], s[1 * 33]); o.y = pk2(s[2 * 33], s[3 * 33]); o.z = pk2(s[4 * 33], s[5 * 33]); o.w = pk2(s[6 * 33], s[7 * 33]);
        *(GAS v4u*)(WT + (size_t)(dst_row + n) * K + k0 + 8 * c) = o; }
    LDS_WAIT(); asm volatile("" ::: "memory");
}
__device__ __forceinline__ int win_src_col(int n) {
    if (n < 4096) return n;
    if (n < 5120) return 4112 + (n - 4096);
    if (n < 7168) { const int t = (n - 5120) >> 8, w = (n - 5120) & 255; return (w < 128) ? (5136 + 128 * t + w) : (6160 + 128 * t + (w - 128)); }
    if (n < 8192) return 7184 + (n - 7168);
    return 8208 + (n - 8192);
}
__device__ __forceinline__ void p0_prologue(Frame& F) {
    LAS float* scr = (LAS float*)(F.lds + RING_OFF + F.wave * 16384);
    const int gw = F.vcu * NWAVES + F.wave, NGW = F.G * NWAVES;
    unsigned char* ws = F.ws;
    constexpr int I_IN = 16 * (NIN_T / 32), I_SQ = 16 * 32, I_KV = 16 * 64, I_UP = 16 * 128, I_DN = 64 * 32;
    constexpr int NITEMS = I_IN + 5 * I_SQ + I_KV + I_UP + I_DN;
    for (int it = gw; it < NITEMS; it += NGW) {
        int r = it;
        if (r < I_IN) { const int nb = r % (NIN_T / 32), kb = r / (NIN_T / 32); p0_transpose_block(F.in[I_WIN], NIN, D, 64 * kb, win_src_col(32 * nb), (bf16*)(ws + WS_WIN), 32 * nb, scr, F.lane); continue; } r -= I_IN;
        bool done = false;
#pragma unroll
        for (int q = 0; q < 5; ++q) {
            if (!done && r < I_SQ) { const int idx = (q == 0) ? I_WGDNO : (q == 1) ? I_WSCO : (q == 2) ? I_WMIX : (q == 3) ? I_WXQ : I_WXO;
                const size_t off = (q == 0) ? WS_WGDNO : (q == 1) ? WS_WSCO : (q == 2) ? WS_WMIX : (q == 3) ? WS_WXQ : WS_WXO;
                const int nb = r % 32, kb = r / 32; p0_transpose_block(F.in[idx], D, D, 64 * kb, 32 * nb, (bf16*)(ws + off), 32 * nb, scr, F.lane); done = true; }
            if (!done) r -= I_SQ;
        }
        if (done) continue;
        if (r < I_KV) { const int nb = r % 64, kb = r / 64; p0_transpose_block(F.in[I_WXKV], 2 * D, D, 64 * kb, 32 * nb, (bf16*)(ws + WS_WXKV), 32 * nb, scr, F.lane); continue; } r -= I_KV;
        if (r < I_UP) { const int nb = r % 128, kb = r / 128; p0_transpose_block(F.in[I_WUP], FF, D, 64 * kb, 32 * nb, (bf16*)(ws + WS_WUP), 32 * nb, scr, F.lane); continue; } r -= I_UP;
        { const int nb = r % 32, kb = r / 32; p0_transpose_block(F.in[I_WDN], D, FF, 64 * kb, 32 * nb, (bf16*)(ws + WS_WDN), 32 * nb, scr, F.lane); }
    }
    __syncthreads();
    LAS float* wab = (LAS float*)(F.lds + RING_OFF);
    for (int e = F.tid; e < 1024 * 4; e += NWAVES * 64) { const int k = e >> 2, q4 = e & 3; const int rho = ((k >> 2) & 63) + 64 * ((k & 3) + 4 * (k >> 8));
        const f32x4 v = *(const GAS f32x4*)(F.in[I_WIN] + (size_t)k * NIN + 4096 + 4 * q4); *(LAS f32x4*)(wab + rho * 20 + 4 * q4) = v; }
    __syncthreads();
    const float* gmix = F.in[I_NMIX];
    f32x4 gw4[4];
#pragma unroll
    for (int j = 0; j < 4; ++j) gw4[j] = *(const GAS f32x4*)(gmix + 4 * F.lane + 256 * j);
    for (int m = gw; m < M; m += NGW) {
        const float* xrow = (m < MP) ? F.in[I_XP] + (size_t)m * D : F.in[I_XS] + (size_t)(m - MP) * D;
        const GAS f32x4* xr = (const GAS f32x4*)xrow + F.lane;
        f32x4 v[4]; float s = 0.f;
#pragma unroll
        for (int j = 0; j < 4; ++j) { v[j] = xr[64 * j]; s += (v[j].x * v[j].x + v[j].y * v[j].y) + (v[j].z * v[j].z + v[j].w * v[j].w); }
        const float rs = 1.f / sqrtf(wave_sum(s) * (1.f / D) + EPS);
#pragma unroll
        for (int j = 0; j < 4; ++j) v[j] = v[j] * rs * gw4[j];
        GAS v2u* o8 = (GAS v2u*)((bf16*)(ws + WS_XN) + (size_t)m * D) + F.lane;
#pragma unroll
        for (int j = 0; j < 4; ++j) { v2u o; o.x = pk2(v[j].x, v[j].y); o.y = pk2(v[j].z, v[j].w); o8[64 * j] = o; }
        float p[16];
#pragma unroll
        for (int o = 0; o < 16; ++o) p[o] = 0.f;
#pragma unroll
        for (int j = 0; j < 4; ++j)
#pragma unroll
            for (int e = 0; e < 4; ++e) { const float hv = v[j][e]; const LAS f32x4* wr = (const LAS f32x4*)(wab + (F.lane + 64 * (e + 4 * j)) * 20);
#pragma unroll
                for (int q4 = 0; q4 < 4; ++q4) { const f32x4 w = wr[q4]; p[4 * q4 + 0] += hv * w.x; p[4 * q4 + 1] += hv * w.y; p[4 * q4 + 2] += hv * w.z; p[4 * q4 + 3] += hv * w.w; }
                if (e & 1) asm volatile("" ::: "memory"); }
        float q8[8], q4v[4], q2[2], q1;
        { const bool hi = (F.lane & 32) != 0;
#pragma unroll
          for (int i = 0; i < 8; ++i) { const float send = hi ? p[i] : p[i + 8], keep = hi ? p[i + 8] : p[i]; q8[i] = keep + __shfl_xor(send, 32); } }
        { const bool hi = (F.lane & 16) != 0;
#pragma unroll
          for (int i = 0; i < 4; ++i) { const float send = hi ? q8[i] : q8[i + 4], keep = hi ? q8[i + 4] : q8[i]; q4v[i] = keep + __shfl_xor(send, 16); } }
        { const bool hi = (F.lane & 8) != 0;
#pragma unroll
          for (int i = 0; i < 2; ++i) { const float send = hi ? q4v[i] : q4v[i + 2], keep = hi ? q4v[i + 2] : q4v[i]; q2[i] = keep + __shfl_xor(send, 8); } }
        { const bool hi = (F.lane & 4) != 0; const float send = hi ? q2[0] : q2[1], keep = hi ? q2[1] : q2[0]; q1 = keep + __shfl_xor(send, 4); }
        q1 += __shfl_xor(q1, 2); q1 += __shfl_xor(q1, 1);
        if ((F.lane & 3) == 0) ((GAS float*)(ws + WS_AB))[(size_t)m * 16 + (F.lane >> 2)] = q1;
    }
    const float* gmem = F.in[I_NMEM];
#pragma unroll
    for (int j = 0; j < 4; ++j) gw4[j] = *(const GAS f32x4*)(gmem + 4 * F.lane + 256 * j);
    for (int m = gw; m < MMEM; m += NGW) {
        const GAS f32x4* xr = (const GAS f32x4*)(F.in[I_MEM] + (size_t)m * D) + F.lane;
        f32x4 v[4]; float s = 0.f;
#pragma unroll
        for (int j = 0; j < 4; ++j) { v[j] = xr[64 * j]; s += (v[j].x * v[j].x + v[j].y * v[j].y) + (v[j].z * v[j].z + v[j].w * v[j].w); }
        const float rs = 1.f / sqrtf(wave_sum(s) * (1.f / D) + EPS);
        GAS v2u* o8 = (GAS v2u*)((bf16*)(ws + WS_MN) + (size_t)m * D) + F.lane;
#pragma unroll
        for (int j = 0; j < 4; ++j) { const f32x4 h = v[j] * rs * gw4[j]; v2u o; o.x = pk2(h.x, h.y); o.y = pk2(h.z, h.w); o8[64 * j] = o; }
    }
    __syncthreads();
}

struct EpiP1 {
    unsigned char* ws; float* out;
    __device__ __forceinline__ void operator()(const pg8::f32x4 (&acc)[2][2][4][2], const pg8::Unit& u, int wr, int wc, int fr, int fq) const {
        bf16* const qkv = (bf16*)(ws + WS_QKV); bf16* const sz = (bf16*)(out + O_Y); bf16* const bg = sz + (size_t)M * D; bf16* const upre = (bf16*)(ws + WS_UPRE);
        bf16* const sga = (bf16*)(ws + WS_SGA); bf16* const sgb = (bf16*)(ws + WS_SGB); bf16* const kb = (bf16*)(ws + WS_KB); bf16* const vt = (bf16*)(ws + WS_VT);
        float* const mk = out + O_MK; float* const mv = out + O_MV;
        const int row0 = u.pm * 256 + wr * 64 + fr, cl = wc * 32 + 8 * fq;
        if (u.g == 0) {
            const int pn = u.pn;
            if (pn >= 20 && pn < 28) {
#pragma unroll
                for (int ai = 0; ai < 2; ++ai)
#pragma unroll
                    for (int m = 0; m < 4; ++m) { const size_t r = (size_t)(row0 + ai * 128 + m * 16);
                        const f32x4 a0 = acc[ai][0][m][0] * acc[ai][1][m][0], a1 = acc[ai][0][m][1] * acc[ai][1][m][1];
                        v4u w; w.x = pk2(a0[0], a0[1]); w.y = pk2(a0[2], a0[3]); w.z = pk2(a1[0], a1[1]); w.w = pk2(a1[2], a1[3]);
                        *(GAS v4u*)(upre + r * D + 128 * (pn - 20) + cl) = w; }
                return;
            }
            bf16* base; int ld, c0, act;
            if (pn < 12) { base = qkv; ld = 3072; c0 = 256 * pn; act = 0; }
            else if (pn < 16) { base = sz; ld = D; c0 = 256 * (pn - 12); act = 1; }
            else if (pn < 20) { base = bg; ld = D; c0 = 256 * (pn - 16); act = 0; }
            else if (pn < 32) { base = sga; ld = D; c0 = 256 * (pn - 28); act = 2; }
            else { base = sgb; ld = D; c0 = 256 * (pn - 32); act = 2; }
#pragma unroll
            for (int ai = 0; ai < 2; ++ai)
#pragma unroll
                for (int m = 0; m < 4; ++m) { bf16* rowp = base + (size_t)(row0 + ai * 128 + m * 16) * ld + c0 + cl;
#pragma unroll
                    for (int bj = 0; bj < 2; ++bj) { f32x4 v0 = acc[ai][bj][m][0], v1 = acc[ai][bj][m][1];
                        if (act == 1) {
#pragma unroll
                            for (int e = 0; e < 4; ++e) { v0[e] = siluf_(v0[e]); v1[e] = siluf_(v1[e]); } }
                        else if (act == 2) {
#pragma unroll
                            for (int e = 0; e < 4; ++e) { v0[e] = sigmoidf_(v0[e]); v1[e] = sigmoidf_(v1[e]); } }
                        v4u w; w.x = pk2(v0[0], v0[1]); w.y = pk2(v0[2], v0[3]); w.z = pk2(v1[0], v1[1]); w.w = pk2(v1[2], v1[3]);
                        *(GAS v4u*)(rowp + bj * 128) = w; } }
        } else if (u.g == 1) {
            const bool isk = u.pn < 4; float* fo = isk ? mk : mv; const int c0 = 256 * (u.pn & 3) + cl;
#pragma unroll
            for (int ai = 0; ai < 2; ++ai)
#pragma unroll
                for (int m = 0; m < 4; ++m) { const size_t r = (size_t)(row0 + ai * 128 + m * 16);
#pragma unroll
                    for (int bj = 0; bj < 2; ++bj) { const f32x4 v0 = acc[ai][bj][m][0], v1 = acc[ai][bj][m][1];
                        *(GAS f32x4*)(fo + r * D + c0 + bj * 128) = v0; *(GAS f32x4*)(fo + r * D + c0 + bj * 128 + 4) = v1;
                        if (isk) { v4u w; w.x = pk2(v0[0], v0[1]); w.y = pk2(v0[2], v0[3]); w.z = pk2(v1[0], v1[1]); w.w = pk2(v1[2], v1[3]);
                            *(GAS v4u*)(kb + r * D + c0 + bj * 128) = w; } } }
        } else {
#pragma unroll
            for (int ai = 0; ai < 2; ++ai)
#pragma unroll
                for (int m = 0; m < 4; ++m) { const size_t r = (size_t)(row0 + ai * 128 + m * 16);
#pragma unroll
                    for (int bj = 0; bj < 2; ++bj) { const int c = 256 * u.pn + bj * 128 + cl;
                        const int b3 = (c >> 3) & 1, cb = c & ~15; const f32x4 v0 = acc[ai][bj][m][0], v1 = acc[ai][bj][m][1];
                        v2u w0, w1; w0.x = pk2(v0[0], v0[1]); w0.y = pk2(v0[2], v0[3]); w1.x = pk2(v1[0], v1[1]); w1.y = pk2(v1[2], v1[3]);
                        *(GAS v2u*)(vt + r * MMEM + cb + 4 * b3) = w0; *(GAS v2u*)(vt + r * MMEM + cb + 8 + 4 * b3) = w1; } }
        }
    }
};


#if MK_TIMING
#define PSTAMP(k) do { if (u == 512 && F.tid == 0) __hip_atomic_store(F.ctl + 1024 + 2 * (20 + (k)), (unsigned)(__builtin_amdgcn_s_memrealtime()), RLX_AGENT); } while (0)
#else
#define PSTAMP(k) do {} while (0)
#endif
typedef float f32x16 __attribute__((ext_vector_type(16)));
#define MFMA32(a, b, c) __builtin_amdgcn_mfma_f32_32x32x16_bf16((a), (b), (c), 0, 0, 0)
__device__ __forceinline__ int crow(int reg, int h) { return (reg & 3) + 8 * (reg >> 2) + 4 * h; }
__device__ __forceinline__ bf16x8 pack_step(const f32x16& x, int s) {
    v4u p; p.x = pk2(x[8 * s + 0], x[8 * s + 1]); p.y = pk2(x[8 * s + 2], x[8 * s + 3]); p.z = pk2(x[8 * s + 4], x[8 * s + 5]); p.w = pk2(x[8 * s + 6], x[8 * s + 7]);
    return __builtin_bit_cast(bf16x8, p);
}
__device__ __forceinline__ float softplusf_(float x) { return x > 20.f ? x : log1pf(__expf(x)); }
constexpr int CH_W = 0, CH_QE = 16384, CH_KE = 32768, CH_UV = 49152, CH_P = 65536, CH_BYTES = 73728;
constexpr size_t WS_GT = WS_AB + 1536 * 1024;
constexpr size_t WS_O = WS_XN;
constexpr int PL_VF = 0, PL_KB = 32768, PL_QB = 50176, PL_LM = 67584, PL_GC = 83968, PL_BT = PL_GC + 256, PL_EG = PL_BT + 256;
constexpr int KBS = 136;

constexpr int PL2_KB = 0, PL2_QB = 17408, PL2_RT = 34816, PL2_GC = 71680, PL2_BT = PL2_GC + 256, PL2_EG = PL2_BT + 256, PL2_BYTES = 72704;
constexpr int RTS = 72, TMS = 68;
__device__ __forceinline__ void gdn_prep_unit(Frame& F, int pu) {
    const int grp = F.wave >> 2, w = F.wave & 3, lane = F.lane;
    const int u = 2 * pu + grp, b = u >> 8, h = (u >> 5) & 7, c = u & 31;
    const size_t row0 = (size_t)b * SEQ + 64 * c;
    unsigned char* ws = F.ws;
    LAS unsigned char* lb = F.lds + grp * PL2_BYTES;
    LAS bf16* kb = (LAS bf16*)(lb + PL2_KB); LAS bf16* qb = (LAS bf16*)(lb + PL2_QB); LAS bf16* rt = (LAS bf16*)(lb + PL2_RT);
    LAS float* Lt = (LAS float*)(lb + PL2_KB); LAS float* Tm = (LAS float*)(lb + PL2_QB);
    LAS float* gcs = (LAS float*)(lb + PL2_GC); LAS float* bts = (LAS float*)(lb + PL2_BT); LAS float* egs = (LAS float*)(lb + PL2_EG);
    unsigned char* rec = ws + WS_R3 + (size_t)u * CH_BYTES;
    PSTAMP(5);
    if (w == 0) {
        const float* ab = (const float*)(ws + WS_AB) + (row0 + lane) * 16;
        const float a = ab[h], bb = ab[8 + h];
        float g = -__expf(F.in[I_ALOG][h]) * softplusf_(a + F.in[I_DTB][h]);
        float gc = g;
#pragma unroll
        for (int o = 1; o < 64; o <<= 1) { const float t = __shfl_up(gc, o); if (lane >= o) gc += t; }
        gcs[lane] = gc; bts[lane] = sigmoidf_(bb); egs[lane] = __expf(gc);
    }
    __syncthreads();
    PSTAMP(6);
    {
        const int cg = lane & 31, rp = lane >> 5;
        const float gl = gcs[63];
        const bf16* qkv = (const bf16*)(ws + WS_QKV);
#pragma unroll
        for (int p = 0; p < 3; ++p) {
            const int colb = p * 1024 + h * 128 + 4 * cg;
            f32x4 wv[4];
#pragma unroll
            for (int i = 0; i < 4; ++i) wv[i] = *(const GAS f32x4*)(F.in[I_GCW] + (size_t)i * 3072 + colb);
            v2u raw[2][7];
#pragma unroll
            for (int k = 0; k < 2; ++k)
#pragma unroll
                for (int r = 0; r < 7; ++r) { const int i0 = 16 * w + 8 * k + 4 * rp; const int t = 64 * c + i0 - 3 + r;
                    raw[k][r] = (v2u){0u, 0u}; if (t >= 0) raw[k][r] = *(const GAS v2u*)(qkv + (row0 + i0 - 3 + r) * 3072 + colb); }
#pragma unroll
            for (int k = 0; k < 2; ++k) {
                const int i0 = 16 * w + 8 * k + 4 * rp;
                float x[7][4];
#pragma unroll
                for (int r = 0; r < 7; ++r) { x[r][0] = bflo(raw[k][r].x); x[r][1] = bfhi(raw[k][r].x); x[r][2] = bflo(raw[k][r].y); x[r][3] = bfhi(raw[k][r].y); }
                float y[4][4];
#pragma unroll
                for (int ro = 0; ro < 4; ++ro)
#pragma unroll
                    for (int e = 0; e < 4; ++e) { float a = 0.f;
#pragma unroll
                        for (int i = 0; i < 4; ++i) a += wv[i][e] * x[ro + i][e];
                        y[ro][e] = siluf_(a); }
                if (p < 2) {
#pragma unroll
                    for (int ro = 0; ro < 4; ++ro) { const float ss = half_sum((y[ro][0] * y[ro][0] + y[ro][1] * y[ro][1]) + (y[ro][2] * y[ro][2] + y[ro][3] * y[ro][3]));
                        const float sc = rsqf_(ss + 1e-6f) * (p == 0 ? 0.08838834764831845f : 1.f);
#pragma unroll
                        for (int e = 0; e < 4; ++e) y[ro][e] *= sc; }
                }
                if (p == 0) {
#pragma unroll
                    for (int ro = 0; ro < 4; ++ro) { const int i = i0 + ro; v2u o; o.x = pk2(y[ro][0], y[ro][1]); o.y = pk2(y[ro][2], y[ro][3]);
                        *(LAS v2u*)(qb + i * KBS + 4 * cg) = o;
                        const float eg = egs[i]; v2u q; q.x = pk2(y[ro][0] * eg, y[ro][1] * eg); q.y = pk2(y[ro][2] * eg, y[ro][3] * eg);
                        const int rb = i >> 5, db = cg >> 3, s2 = (cg >> 2) & 1, a2 = (cg >> 1) & 1, hh = cg & 1;
                        *(GAS v2u*)(rec + CH_QE + ((((rb * 4 + db) * 2 + s2) * 64 + (i & 31) + 32 * hh) * 8 + 4 * a2) * 2) = q; }
                } else {
                    float sk[4], ek[4];
#pragma unroll
                    for (int ro = 0; ro < 4; ++ro) { const int i = i0 + ro; sk[ro] = bts[i] * (p == 1 ? egs[i] : 1.f); ek[ro] = __expf(gl - gcs[i]); }
                    if (p == 1) {
#pragma unroll
                        for (int ro = 0; ro < 4; ++ro) { const int i = i0 + ro; v2u o; o.x = pk2(y[ro][0], y[ro][1]); o.y = pk2(y[ro][2], y[ro][3]);
                            *(LAS v2u*)(kb + i * KBS + 4 * cg) = o; }
                        const int rb = i0 >> 5, rho = i0 & 31, s2 = (rho >> 4) & 1, a2 = (rho >> 3) & 1, hh = (rho >> 2) & 1, db = cg >> 3;
#pragma unroll
                        for (int e = 0; e < 4; ++e) { const int r = 4 * (cg & 7) + e; v2u o; o.x = pk2(y[0][e] * ek[0], y[1][e] * ek[1]); o.y = pk2(y[2][e] * ek[2], y[3][e] * ek[3]);
                            *(GAS v2u*)(rec + CH_KE + ((((db * 2 + rb) * 2 + s2) * 64 + r + 32 * hh) * 8 + 4 * a2) * 2) = o; }
                    }
#pragma unroll
                    for (int e = 0; e < 4; ++e) { v2u o; o.x = pk2(y[0][e] * sk[0], y[1][e] * sk[1]); o.y = pk2(y[2][e] * sk[2], y[3][e] * sk[3]);
                        *(LAS v2u*)(rt + ((p - 1) * 128 + 4 * cg + e) * RTS + i0) = o; }
                }
            }
        }
    }
    __syncthreads();
    PSTAMP(7);
    const int ti = (w == 0) ? 0 : 1, tj = (w == 2) ? 1 : 0, r = lane & 31, hh = lane >> 5;
    f32x16 acc, accp;
#pragma unroll
    for (int i = 0; i < 16; ++i) { acc[i] = 0.f; accp[i] = 0.f; }
    if (w < 3) {
#pragma unroll
        for (int s2 = 0; s2 < 8; ++s2) {
            const bf16x8 ki = *(const LAS bf16x8*)(kb + (32 * ti + r) * KBS + 16 * s2 + 8 * hh);
            const bf16x8 kj = *(const LAS bf16x8*)(kb + (32 * tj + r) * KBS + 16 * s2 + 8 * hh);
            const bf16x8 qi = *(const LAS bf16x8*)(qb + (32 * ti + r) * KBS + 16 * s2 + 8 * hh);
            acc = MFMA32(ki, kj, acc);
            accp = MFMA32(kj, qi, accp);
        }
    }
    __syncthreads();
    if (w < 3) {
        int r_ = lane & 31, hh_ = lane >> 5; asm volatile("" : "+v"(r_), "+v"(hh_));
        const int r = r_, hh = hh_;
        {
            const int j = 32 * tj + r; const float gcj = gcs[j];
#pragma unroll
            for (int g4 = 0; g4 < 4; ++g4) { f32x4 o;
#pragma unroll
                for (int e = 0; e < 4; ++e) { const int i = 32 * ti + crow(4 * g4 + e, hh); o[e] = (i > j) ? bts[i] * acc[4 * g4 + e] * __expf(fminf(gcs[i] - gcj, 0.f)) : 0.f; }
                *(LAS f32x4*)(Lt + j * 64 + 32 * ti + 8 * g4 + 4 * hh) = o; }
        }
        {   const int i = 32 * ti + r; const float gci = gcs[i];
#pragma unroll
            for (int q = 0; q < 16; ++q) { const int j = 32 * tj + crow(q, hh); accp[q] = (i >= j) ? accp[q] * __expf(fminf(gci - gcs[j], 0.f)) : 0.f; }
#pragma unroll
            for (int s2 = 0; s2 < 2; ++s2) *(GAS bf16x8*)(rec + CH_P + (((ti * 2 + tj) * 2 + s2) * 64 + lane) * 16) = pack_step(accp, s2);
        }
    }
    __syncthreads();
    PSTAMP(8);
    if (w == 0) {
        const int cc = lane & 31, hf = lane >> 5;
        unsigned ltb = (unsigned)(size_t)(Lt + hf * (32 * 64 + 32)); asm volatile("" : "+v"(ltb)); const LAS float* Lp = (const LAS float*)ltb;
        float x[32];
#pragma unroll
        for (int i = 0; i < 32; ++i) x[i] = (i == cc) ? 1.f : 0.f;
#pragma unroll
        for (int j = 0; j < 31; ++j) {
            const float xj = x[j];
#pragma unroll
            for (int i4 = (j + 1) / 4; i4 < 8; ++i4) { const f32x4 l = *(const LAS f32x4*)(Lp + j * 64 + 4 * i4);
#pragma unroll
                for (int e = 0; e < 4; ++e) { const int i = 4 * i4 + e; if (i > j) x[i] -= l[e] * xj; } }
            if ((j & 3) == 3) asm volatile("" ::: "memory");
        }
        unsigned tmb = (unsigned)(size_t)(Tm + hf * (32 * TMS + 32) + cc); asm volatile("" : "+v"(tmb)); LAS float* Tp = (LAS float*)tmb;
#pragma unroll
        for (int i = 0; i < 32; ++i) Tp[i * TMS] = x[i];
        if (hf == 1) {
#pragma unroll
            for (int i = 0; i < 32; ++i) Tp[i * TMS - 32 * TMS] = 0.f;
        }
    }
    __syncthreads();
    if (w == 0) {
        f32x16 m1, t10;
#pragma unroll
        for (int i = 0; i < 16; ++i) { m1[i] = 0.f; t10[i] = 0.f; }
#pragma unroll
        for (int s2 = 0; s2 < 16; ++s2) m1 = __builtin_amdgcn_mfma_f32_32x32x2f32(Lt[(2 * s2 + hh) * 64 + 32 + r], Tm[(2 * s2 + hh) * TMS + r], m1, 0, 0, 0);
#pragma unroll
        for (int q = 0; q < 16; ++q) t10 = __builtin_amdgcn_mfma_f32_32x32x2f32(Tm[(32 + r) * TMS + 32 + crow(q, hh)], m1[q], t10, 0, 0, 0);
#pragma unroll
        for (int q = 0; q < 16; ++q) Tm[(32 + crow(q, hh)) * TMS + r] = -t10[q];
    }
    __syncthreads();
    PSTAMP(9);
#pragma unroll
    for (int cs = 0; cs < 2; ++cs) {
        const int ct = 2 * w + cs;
#pragma unroll
        for (int rb = 0; rb < 2; ++rb) {
            f32x16 a;
#pragma unroll
            for (int i = 0; i < 16; ++i) a[i] = 0.f;
#pragma unroll
            for (int s2 = 0; s2 < 4; ++s2) if (s2 < 2 || rb == 1) {
                const LAS float* tp = Tm + (32 * rb + r) * TMS + 16 * s2 + 8 * hh;
                const f32x4 t0 = *(const LAS f32x4*)tp, t1 = *(const LAS f32x4*)(tp + 4);
                const v4u tv = {pk2(t0[0], t0[1]), pk2(t0[2], t0[3]), pk2(t1[0], t1[1]), pk2(t1[2], t1[3])};
                const bf16x8 tf = __builtin_bit_cast(bf16x8, tv);
                const bf16x8 rf = *(const LAS bf16x8*)(rt + (32 * ct + r) * RTS + 16 * s2 + 8 * hh);
                a = (ct < 4) ? MFMA32(rf, tf, a) : MFMA32(tf, rf, a);
            }
            if (ct < 4) {
#pragma unroll
                for (int s2 = 0; s2 < 2; ++s2) *(GAS bf16x8*)(rec + CH_W + (((rb * 4 + ct) * 2 + s2) * 64 + lane) * 16) = pack_step(a, s2);
            } else {
#pragma unroll
                for (int g4 = 0; g4 < 4; ++g4) *(GAS v2u*)(rec + CH_UV + (((rb * 4 + (ct - 4)) * 4 + g4) * 64 + lane) * 8) = (v2u){pk2(a[4 * g4], a[4 * g4 + 1]), pk2(a[4 * g4 + 2], a[4 * g4 + 3])};
            }
        }
    }
    if ((F.tid & 255) == 0) ((GAS float*)(ws + WS_GT))[u] = egs[63];
    __syncthreads();
    PSTAMP(10);
}

__device__ __forceinline__ void gdn_sample_unit(Frame& F, int su) {
    const int sl = __builtin_amdgcn_readfirstlane(F.tid >> 7), cc = F.tid & 127, sq = 4 * su + sl, b = sq >> 3, h = sq & 7;
    unsigned char* ws = F.ws;
    LAS float* base = (LAS float*)(F.lds + sl * 16384);
    LAS float* qs = base, *ks = base + 1024, *vs = base + 2048, *egs = base + 3072, *bts = base + 3088;
    const bf16* qkv = (const bf16*)(ws + WS_QKV);
    const size_t rowb = (size_t)MP + (size_t)b * DS;
#pragma unroll
    for (int p = 0; p < 3; ++p) {
        const int col = p * 1024 + h * 128 + cc; float xx[11];
#pragma unroll
        for (int r = 0; r < 3; ++r) xx[r] = F.in[I_SGC][((size_t)b * 3 + r) * 3072 + col];
#pragma unroll
        for (int t = 0; t < 8; ++t) xx[3 + t] = bf2f(qkv[(rowb + t) * 3072 + col]);
        float wv[4];
#pragma unroll
        for (int i = 0; i < 4; ++i) wv[i] = F.in[I_GCW][(size_t)i * 3072 + col];
        LAS float* dst = (p == 0) ? qs : (p == 1) ? ks : vs;
#pragma unroll
        for (int t = 0; t < 8; ++t) { const float a = wv[0] * xx[t] + wv[1] * xx[t + 1] + wv[2] * xx[t + 2] + wv[3] * xx[t + 3]; dst[t * 128 + cc] = siluf_(a); }
    }
    if (cc < 8) { const float* ab = (const float*)(ws + WS_AB) + (rowb + cc) * 16;
        const float g = -__expf(F.in[I_ALOG][h]) * softplusf_(ab[h] + F.in[I_DTB][h]); egs[cc] = __expf(g); bts[cc] = sigmoidf_(ab[8 + h]); }
    float S[128];
    const float* s0 = F.in[I_SG] + ((size_t)(b * 8 + h) * 128) * 128 + cc;
#pragma unroll
    for (int dk = 0; dk < 128; ++dk) S[dk] = s0[(size_t)dk * 128];
    __syncthreads();
    for (int t = 0; t < 8; ++t) {
        float ssk = 0.f, kS = 0.f;
#pragma unroll
        for (int d4 = 0; d4 < 32; ++d4) { const f32x4 kv = *(const LAS f32x4*)(ks + t * 128 + 4 * d4);
#pragma unroll
            for (int e = 0; e < 4; ++e) { ssk += kv[e] * kv[e]; kS += S[4 * d4 + e] * kv[e]; }
            if ((d4 & 3) == 3) asm volatile("" ::: "memory"); }
        const float rk = 1.f / sqrtf(ssk + 1e-6f), eg = egs[t];
        const float uu = bts[t] * (vs[t * 128 + cc] - eg * kS * rk) * rk;
        float ssq = 0.f, o = 0.f;
#pragma unroll
        for (int d4 = 0; d4 < 32; ++d4) { const f32x4 kv = *(const LAS f32x4*)(ks + t * 128 + 4 * d4); const f32x4 qv = *(const LAS f32x4*)(qs + t * 128 + 4 * d4);
#pragma unroll
            for (int e = 0; e < 4; ++e) { const float sn = eg * S[4 * d4 + e] + kv[e] * uu; S[4 * d4 + e] = sn; ssq += qv[e] * qv[e]; o += sn * qv[e]; }
            if ((d4 & 1) == 1) asm volatile("" ::: "memory"); }
        o *= (1.f / sqrtf(ssq + 1e-6f)) * 0.08838834764831845f;
        ((bf16*)(ws + WS_O))[(rowb + t) * D + h * 128 + cc] = (bf16)(pk2(o, 0.f) & 0xffffu);
    }
    float* so = F.out + O_GSS + ((size_t)(b * 8 + h) * 128) * 128 + cc;
#pragma unroll
    for (int dk = 0; dk < 128; ++dk) so[(size_t)dk * 128] = S[dk];
    __syncthreads();
}

__device__ __forceinline__ void sc_conv_pass(Frame& F) {
    const bf16* upre = (const bf16*)(F.ws + WS_UPRE); bf16* bgp = (bf16*)(F.out + O_Y) + (size_t)M * D;
    const size_t gt = (size_t)F.vcu * (NWAVES * 64) + F.tid, NT = (size_t)F.G * NWAVES * 64;
#pragma unroll 2
    for (size_t it = gt; it < (size_t)M * 128; it += NT) {
        const size_t row = it >> 7; const int c8 = (int)(it & 127) * 8;
        const bool smp = row >= MP; const int t = smp ? (int)((row - MP) & 7) : (int)(row & (SEQ - 1)); const int sb = smp ? (int)((row - MP) >> 3) : 0;
        float xm[3][8];
        { const v4u r = *(const GAS v4u*)(upre + row * D + c8); xm[2][0] = bflo(r.x); xm[2][1] = bfhi(r.x); xm[2][2] = bflo(r.y); xm[2][3] = bfhi(r.y); xm[2][4] = bflo(r.z); xm[2][5] = bfhi(r.z); xm[2][6] = bflo(r.w); xm[2][7] = bfhi(r.w); }
#pragma unroll
        for (int k = 1; k <= 2; ++k) {
            if (t - k >= 0) { const v4u r = *(const GAS v4u*)(upre + (row - k) * D + c8);
                xm[2 - k][0] = bflo(r.x); xm[2 - k][1] = bfhi(r.x); xm[2 - k][2] = bflo(r.y); xm[2 - k][3] = bfhi(r.y); xm[2 - k][4] = bflo(r.z); xm[2 - k][5] = bfhi(r.z); xm[2 - k][6] = bflo(r.w); xm[2 - k][7] = bfhi(r.w); }
            else if (smp) { const float* sp = F.in[I_SSC] + ((size_t)sb * 2 + (2 + t - k)) * D + c8;
#pragma unroll
                for (int e = 0; e < 8; ++e) xm[2 - k][e] = sp[e]; }
            else {
#pragma unroll
                for (int e = 0; e < 8; ++e) xm[2 - k][e] = 0.f; }
        }
        const v4u br = *(const GAS v4u*)(bgp + row * D + c8);
        float bgv[8] = {bflo(br.x), bfhi(br.x), bflo(br.y), bfhi(br.y), bflo(br.z), bfhi(br.z), bflo(br.w), bfhi(br.w)};
        float o[8];
#pragma unroll
        for (int e = 0; e < 8; ++e) { const float w0 = F.in[I_SCW][c8 + e], w1 = F.in[I_SCW][D + c8 + e], w2 = F.in[I_SCW][2 * D + c8 + e];
            o[e] = bgv[e] * (w0 * xm[0][e] + w1 * xm[1][e] + w2 * xm[2][e]); }
        *(GAS v4u*)(bgp + row * D + c8) = (v4u){pk2(o[0], o[1]), pk2(o[2], o[3]), pk2(o[4], o[5]), pk2(o[6], o[7])};
    }
}

__device__ __forceinline__ void gdn_scan_unit(Frame& F, int bh) {
    unsigned char* ws = F.ws; const int lane = F.lane, dvl = lane & 31, hh = lane >> 5, w = F.wave;
    const int b = bh >> 3, h = bh & 7;
    const unsigned char* rec0 = ws + WS_R3 + (size_t)bh * 32 * CH_BYTES;
    const unsigned l16 = (unsigned)lane * 16u;
    __syncthreads();
    if (w >= 4) {
        const int lw = w - 4;
#pragma unroll
        for (int k = 0; k < 18; ++k) { const int pz = lw * 18 + k;
            __builtin_amdgcn_global_load_lds((const unsigned*)(rec0 + (size_t)pz * 1024 + l16), (LAS unsigned*)(F.lds + pz * 1024), 16, 0, 0); }
        asm volatile("s_waitcnt vmcnt(0)" ::: "memory");
    }
    __syncthreads();
    f32x16 S[4];
#pragma unroll
    for (int d = 0; d < 4; ++d)
#pragma unroll
        for (int i = 0; i < 16; ++i) S[d][i] = 0.f;
    const float gtv = ((const GAS float*)(ws + WS_GT))[bh * 32 + (lane & 31)];
    bf16* Og = (bf16*)(ws + WS_O);
    const int vsl = w & 3;
    for (int c = 0; c < 32; ++c) {
        if (w >= 4) {
            if (c + 1 < 32 && MK_EXP != 2) { const int lw = w - 4; const unsigned char* rn = rec0 + (size_t)(c + 1) * CH_BYTES; const int bo = ((c + 1) & 1) * CH_BYTES;
#pragma unroll
                for (int k = 0; k < 18; ++k) { const int pz = lw * 18 + k;
                    __builtin_amdgcn_global_load_lds((const unsigned*)(rn + (size_t)pz * 1024 + l16), (LAS unsigned*)(F.lds + bo + pz * 1024), 16, 0, 0); }
                asm volatile("s_waitcnt vmcnt(0)" ::: "memory"); }
        } else if (MK_EXP != 1) {
            const LAS unsigned char* rec = F.lds + (c & 1) * CH_BYTES + l16;
            const float gt = __shfl(gtv, c);
            bf16x8 Sb[4][2];
#pragma unroll
            for (int d = 0; d < 4; ++d) { Sb[d][0] = pack_step(S[d], 0); Sb[d][1] = pack_step(S[d], 1); }
            f32x16 U[2];
#pragma unroll
            for (int rb = 0; rb < 2; ++rb) {
                f32x16 a;
#pragma unroll
                for (int i = 0; i < 16; ++i) a[i] = 0.f;
#pragma unroll
                for (int d = 0; d < 4; ++d)
#pragma unroll
                    for (int s2 = 0; s2 < 2; ++s2) a = MFMA32(*(const LAS bf16x8*)(rec + (CH_W + ((rb * 4 + d) * 2 + s2) * 1024)), Sb[d][s2], a);
                const LAS unsigned char* uvp = F.lds + (c & 1) * CH_BYTES + CH_UV + (rb * 16 + vsl * 4) * 512 + lane * 8;
#pragma unroll
                for (int g4 = 0; g4 < 4; ++g4) { const v2u uv = *(const LAS v2u*)(uvp + g4 * 512);
                    a[4 * g4 + 0] = bflo(uv.x) - a[4 * g4 + 0]; a[4 * g4 + 1] = bfhi(uv.x) - a[4 * g4 + 1]; a[4 * g4 + 2] = bflo(uv.y) - a[4 * g4 + 2]; a[4 * g4 + 3] = bfhi(uv.y) - a[4 * g4 + 3]; }
                U[rb] = a;
                asm volatile("" ::: "memory");
            }
            bf16x8 Ub[2][2];
#pragma unroll
            for (int rb = 0; rb < 2; ++rb) { Ub[rb][0] = pack_step(U[rb], 0); Ub[rb][1] = pack_step(U[rb], 1); }
#pragma unroll
            for (int rb = 0; rb < 2; ++rb) {
                f32x16 o;
#pragma unroll
                for (int i = 0; i < 16; ++i) o[i] = 0.f;
#pragma unroll
                for (int d = 0; d < 4; ++d)
#pragma unroll
                    for (int s2 = 0; s2 < 2; ++s2) o = MFMA32(*(const LAS bf16x8*)(rec + (CH_QE + ((rb * 4 + d) * 2 + s2) * 1024)), Sb[d][s2], o);
#pragma unroll
                for (int tj = 0; tj < 2; ++tj) if (tj <= rb)
#pragma unroll
                    for (int s2 = 0; s2 < 2; ++s2) o = MFMA32(*(const LAS bf16x8*)(rec + (CH_P + ((rb * 2 + tj) * 2 + s2) * 1024)), Ub[tj][s2], o);
                bf16* op = Og + ((size_t)b * SEQ + 64 * c + 32 * rb + 4 * hh) * D + h * 128 + 32 * vsl + dvl; asm volatile("" : "+v"(op));
#pragma unroll
                for (int q = 0; q < 16; ++q) op[(size_t)((q & 3) + 8 * (q >> 2)) * D] = (bf16)(pk2(o[q], 0.f) & 0xffffu);
                asm volatile("" ::: "memory");
            }
#pragma unroll
            for (int d = 0; d < 4; ++d) {
                f32x16 a = S[d] * gt;
#pragma unroll
                for (int rb = 0; rb < 2; ++rb)
#pragma unroll
                    for (int s2 = 0; s2 < 2; ++s2) a = MFMA32(*(const LAS bf16x8*)(rec + (CH_KE + ((d * 2 + rb) * 2 + s2) * 1024)), Ub[rb][s2], a);
                S[d] = a;
                if (d & 1) asm volatile("" ::: "memory");
            }
        }
        __syncthreads();
    }
    if (w < 4) {
        float* so = F.out + O_GSP + ((size_t)bh * 128 + 4 * hh) * 128 + 32 * vsl + dvl; asm volatile("" : "+v"(so));
#pragma unroll
        for (int d = 0; d < 4; ++d)
#pragma unroll
            for (int q = 0; q < 16; ++q) so[(size_t)(32 * d + (q & 3) + 8 * (q >> 2)) * 128] = S[d][q];
    }
}

__device__ __forceinline__ void og_pass(Frame& F) {
    bf16* Og = (bf16*)(F.ws + WS_O); const bf16* sz = (const bf16*)(F.out + O_Y);
    const int gw = F.vcu * NWAVES + F.wave, NGW = F.G * NWAVES;
    const float w0 = F.in[I_GON][2 * F.lane], w1 = F.in[I_GON][2 * F.lane + 1];
    for (int m = gw; m < M; m += NGW) {
        unsigned ov[8], zv[8];
#pragma unroll
        for (int hd = 0; hd < 8; ++hd) { ov[hd] = *(const GAS unsigned*)(Og + (size_t)m * D + hd * 128 + 2 * F.lane); zv[hd] = *(const GAS unsigned*)(sz + (size_t)m * D + hd * 128 + 2 * F.lane); }
#pragma unroll
        for (int hd = 0; hd < 8; ++hd) { const float a = bflo(ov[hd]), bq = bfhi(ov[hd]);
            const float rs = 1.f / sqrtf(wave_sum(a * a + bq * bq) * (1.f / 128.f) + EPS);
            *(GAS unsigned*)(Og + (size_t)m * D + hd * 128 + 2 * F.lane) = pk2(a * rs * w0 * bflo(zv[hd]), bq * rs * w1 * bfhi(zv[hd])); }
    }
}


__device__ __forceinline__ void unpack8(const v4u r, float (&o)[8]) { o[0] = bflo(r.x); o[1] = bfhi(r.x); o[2] = bflo(r.y); o[3] = bfhi(r.y); o[4] = bflo(r.z); o[5] = bfhi(r.z); o[6] = bflo(r.w); o[7] = bfhi(r.w); }
struct EpiP3 {
    unsigned char* ws; int gsel;
    __device__ __forceinline__ void operator()(const pg8::f32x4 (&acc)[2][2][4][2], const pg8::Unit& u_, int wr, int wc, int fr, int fq) const {
        pg8::Unit u = u_; u.g = gsel;
        const bf16* gate = (const bf16*)(ws + (u.g == 0 ? WS_SGB : WS_SGA)); bf16* yb = (bf16*)(ws + WS_YB); bf16* mg = (bf16*)(ws + WS_MG);
        const int row0 = u.pm * 256 + wr * 64 + fr, col0 = u.pn * 256 + wc * 32 + 8 * fq;
#pragma unroll
        for (int ai = 0; ai < 2; ++ai)
#pragma unroll
            for (int m = 0; m < 4; ++m) { const size_t ro = (size_t)(row0 + ai * 128 + m * 16) * D + col0;
#pragma unroll
                for (int bj = 0; bj < 2; ++bj) { float gv[8]; unpack8(*(const GAS v4u*)(gate + ro + bj * 128), gv);
                    float v[8];
#pragma unroll
                    for (int e = 0; e < 4; ++e) { v[e] = acc[ai][bj][m][0][e] * gv[e]; v[4 + e] = acc[ai][bj][m][1][e] * gv[4 + e]; }
                    if (u.g == 1) { float y[8]; unpack8(*(const GAS v4u*)(yb + ro + bj * 128), y);
#pragma unroll
                        for (int e = 0; e < 8; ++e) v[e] += y[e]; }
                    const v4u w = {pk2(v[0], v[1]), pk2(v[2], v[3]), pk2(v[4], v[5]), pk2(v[6], v[7])};
                    *(GAS v4u*)((u.g == 0 ? yb : mg) + ro + bj * 128) = w; } }
    }
};
template <bool FIRST> struct EpiRes {
    const float* xp; const float* xsmp; float* xo; const float* gain; bf16* an; float* ssq; bool write_a;
    __device__ __forceinline__ void operator()(const pg8::f32x4 (&acc)[2][2][4][2], const pg8::Unit& u, int wr, int wc, int fr, int fq) const {
        const int row0 = u.pm * 256 + wr * 64 + fr, col0 = u.pn * 256 + wc * 32 + 8 * fq;
        f32x4 gv[2][2];
#pragma unroll
        for (int bj = 0; bj < 2; ++bj) { gv[bj][0] = *(const GAS f32x4*)(gain + col0 + bj * 128); gv[bj][1] = *(const GAS f32x4*)(gain + col0 + bj * 128 + 4); }
#pragma unroll
        for (int ai = 0; ai < 2; ++ai)
#pragma unroll
            for (int m = 0; m < 4; ++m) { const int row = row0 + ai * 128 + m * 16; const size_t ro = (size_t)row * D + col0;
                const float* src = FIRST ? ((row < MP) ? xp + ro : xsmp + (ro - (size_t)MP * D)) : xo + ro;
                float ss = 0.f;
#pragma unroll
                for (int bj = 0; bj < 2; ++bj) {
                    const f32x4 x0 = *(const GAS f32x4*)(src + bj * 128) + acc[ai][bj][m][0], x1 = *(const GAS f32x4*)(src + bj * 128 + 4) + acc[ai][bj][m][1];
                    *(GAS f32x4*)(xo + ro + bj * 128) = x0; *(GAS f32x4*)(xo + ro + bj * 128 + 4) = x1;
                    ss += (x0[0] * x0[0] + x0[1] * x0[1]) + (x0[2] * x0[2] + x0[3] * x0[3]) + (x1[0] * x1[0] + x1[1] * x1[1]) + (x1[2] * x1[2] + x1[3] * x1[3]);
                    if (write_a) { const f32x4 a0 = x0 * gv[bj][0], a1 = x1 * gv[bj][1];
                        *(GAS v4u*)(an + ro + bj * 128) = (v4u){pk2(a0[0], a0[1]), pk2(a0[2], a0[3]), pk2(a1[0], a1[1]), pk2(a1[2], a1[3])}; } }
                ss += __shfl_xor(ss, 16); ss += __shfl_xor(ss, 32);
                if (fq == 0) ssq[(size_t)row * 16 + u.pn * 4 + wc] = ss; }
    }
};
__device__ __forceinline__ float row_rs(const float* ssq, int row) {
    const f32x4 a = *(const GAS f32x4*)(ssq + (size_t)row * 16), b = *(const GAS f32x4*)(ssq + (size_t)row * 16 + 4), c = *(const GAS f32x4*)(ssq + (size_t)row * 16 + 8), d = *(const GAS f32x4*)(ssq + (size_t)row * 16 + 12);
    const float s = ((a[0] + a[1]) + (a[2] + a[3])) + ((b[0] + b[1]) + (b[2] + b[3])) + ((c[0] + c[1]) + (c[2] + c[3])) + ((d[0] + d[1]) + (d[2] + d[3]));
    return 1.f / sqrtf(s * (1.f / D) + EPS);
}
template <int ACT> struct EpiScale {
    const float* ssq; bf16* o; int ldc; float scale;
    __device__ __forceinline__ void operator()(const pg8::f32x4 (&acc)[2][2][4][2], const pg8::Unit& u, int wr, int wc, int fr, int fq) const {
        const int row0 = u.pm * 256 + wr * 64 + fr, col0 = u.pn * 256 + wc * 32 + 8 * fq;
#pragma unroll
        for (int ai = 0; ai < 2; ++ai)
#pragma unroll
            for (int m = 0; m < 4; ++m) { const int row = row0 + ai * 128 + m * 16; const float rs = row_rs(ssq, row) * scale;
#pragma unroll
                for (int bj = 0; bj < 2; ++bj) { f32x4 v0 = acc[ai][bj][m][0] * rs, v1 = acc[ai][bj][m][1] * rs;
                    if (ACT == 1) {
#pragma unroll
                        for (int e = 0; e < 4; ++e) { const float a = fmaxf(v0[e], 0.f), b = fmaxf(v1[e], 0.f); v0[e] = a * a; v1[e] = b * b; } }
                    *(GAS v4u*)(o + (size_t)row * ldc + col0 + bj * 128) = (v4u){pk2(v0[0], v0[1]), pk2(v0[2], v0[3]), pk2(v1[0], v1[1]), pk2(v1[2], v1[3])}; } }
    }
};


typedef float f32x4s __attribute__((ext_vector_type(4)));
template <int K> __device__ __forceinline__ void skinny_tile(Frame& F, const bf16* A, const bf16* Bt, float (&v)[8]) {
    const int w = F.wave, lane = F.lane, fr = lane & 15, fq = lane >> 4;
    constexpr int KW = K / 8, NS = KW / 32;
    f32x4 acc[4][4];
#pragma unroll
    for (int i = 0; i < 4; ++i)
#pragma unroll
        for (int j = 0; j < 4; ++j) acc[i][j] = (f32x4){0.f, 0.f, 0.f, 0.f};
    const bf16* ap = A + (size_t)fr * K + w * KW + 8 * fq; const bf16* bp = Bt + (size_t)fr * K + w * KW + 8 * fq;
    constexpr int DEPTH = 4;
    static_assert(NS % DEPTH == 0, "k-steps per wave must be a multiple of the ring depth");
    bf16x8 af[DEPTH][4], bfm[DEPTH][4];
#pragma unroll
    for (int d = 0; d < DEPTH; ++d)
#pragma unroll
        for (int i = 0; i < 4; ++i) { af[d][i] = *(const GAS bf16x8*)(ap + (size_t)(16 * i) * K + 32 * d); bfm[d][i] = *(const GAS bf16x8*)(bp + (size_t)(16 * i) * K + 32 * d); }
    for (int ks0 = 0; ks0 < NS; ks0 += DEPTH) {
#pragma unroll
        for (int d = 0; d < DEPTH; ++d) {
#pragma unroll
            for (int i = 0; i < 4; ++i)
#pragma unroll
                for (int j = 0; j < 4; ++j) acc[i][j] = __builtin_amdgcn_mfma_f32_16x16x32_bf16(bfm[d][j], af[d][i], acc[i][j], 0, 0, 0);
            if (ks0 + DEPTH < NS) {
#pragma unroll
                for (int i = 0; i < 4; ++i) { af[d][i] = *(const GAS bf16x8*)(ap + (size_t)(16 * i) * K + 32 * (ks0 + DEPTH + d)); bfm[d][i] = *(const GAS bf16x8*)(bp + (size_t)(16 * i) * K + 32 * (ks0 + DEPTH + d)); }
            }
        }
    }
    LAS float* part = (LAS float*)(F.lds) + w * (64 * 68);
#pragma unroll
    for (int i = 0; i < 4; ++i)
#pragma unroll
        for (int j = 0; j < 4; ++j) *(LAS f32x4*)(part + (16 * i + fr) * 68 + 16 * j + 4 * fq) = acc[i][j];
    __syncthreads();
    const LAS float* rd = (const LAS float*)(F.lds) + (F.tid >> 3) * 68 + 8 * (F.tid & 7);
    f32x4 s0 = {0.f, 0.f, 0.f, 0.f}, s1 = {0.f, 0.f, 0.f, 0.f};
#pragma unroll
    for (int q = 0; q < 8; ++q) { s0 += *(const LAS f32x4*)(rd + q * (64 * 68)); s1 += *(const LAS f32x4*)(rd + q * (64 * 68) + 4); }
#pragma unroll
    for (int e = 0; e < 4; ++e) { v[e] = s0[e]; v[4 + e] = s1[e]; }
    __syncthreads();
}
__device__ __forceinline__ v4u pack8(const float (&v)[8]) { return (v4u){pk2(v[0], v[1]), pk2(v[2], v[3]), pk2(v[4], v[5]), pk2(v[6], v[7])}; }
__device__ __forceinline__ float sum8x(float ss) { ss += dpp_f<0xB1>(ss); ss += dpp_f<0x4E>(ss); ss += __shfl_xor(ss, 4); return ss; }
template <int MODE> __device__ __forceinline__ void skinny_phase(Frame& F) {
    unsigned char* ws = F.ws; float* ssq = (float*)(ws + WS_SSQ);
    constexpr int NT = (MODE == 8) ? (MS / 64) * (FF / 64) : (MS / 64) * (D / 64);
    constexpr int NCT = (MODE == 8) ? FF / 64 : D / 64;
    for (int t = F.vcu; t < NT; t += F.G) {
        const int tr = t / NCT, tc = t % NCT; const size_t r0 = (size_t)MP + 64 * tr; const int c0 = 64 * tc;
        const size_t row = r0 + (F.tid >> 3); const int col = c0 + 8 * (F.tid & 7);
        float v[8];
        if (MODE == 3) {
            const bf16* ub = (const bf16*)(F.out + O_Y) + (size_t)M * D;
            skinny_tile<D>(F, ub + r0 * D, (const bf16*)(ws + WS_WSCO) + (size_t)c0 * D, v);
            float g[8]; unpack8(*(const GAS v4u*)((const bf16*)(ws + WS_SGB) + row * D + col), g);
            float y1[8];
#pragma unroll
            for (int e = 0; e < 8; ++e) y1[e] = v[e] * g[e];
            skinny_tile<D>(F, (const bf16*)(ws + WS_O) + r0 * D, (const bf16*)(ws + WS_WGDNO) + (size_t)c0 * D, v);
            unpack8(*(const GAS v4u*)((const bf16*)(ws + WS_SGA) + row * D + col), g);
#pragma unroll
            for (int e = 0; e < 8; ++e) v[e] = v[e] * g[e] + y1[e];
            *(GAS v4u*)((bf16*)(ws + WS_MG) + row * D + col) = pack8(v);
        } else if (MODE == 4 || MODE == 7 || MODE == 9) {
            if (MODE == 4) skinny_tile<D>(F, (const bf16*)(ws + WS_MG) + r0 * D, (const bf16*)(ws + WS_WMIX) + (size_t)c0 * D, v);
            else if (MODE == 7) skinny_tile<D>(F, (const bf16*)(ws + WS_CTX) + r0 * D, (const bf16*)(ws + WS_WXO) + (size_t)c0 * D, v);
            else skinny_tile<FF>(F, (const bf16*)(ws + WS_HB) + r0 * FF, (const bf16*)(ws + WS_WDN) + (size_t)c0 * FF, v);
            float* xo = F.out + O_Y + row * D + col;
            const float* src = (MODE == 4) ? F.in[I_XS] + (row - MP) * D + col : xo;
            const f32x4 x0 = *(const GAS f32x4*)src, x1 = *(const GAS f32x4*)(src + 4);
            float ss = 0.f;
#pragma unroll
            for (int e = 0; e < 4; ++e) { v[e] += x0[e]; v[4 + e] += x1[e]; }
#pragma unroll
            for (int e = 0; e < 8; ++e) ss += v[e] * v[e];
            *(GAS f32x4*)xo = (f32x4){v[0], v[1], v[2], v[3]}; *(GAS f32x4*)(xo + 4) = (f32x4){v[4], v[5], v[6], v[7]};
            if (MODE != 9) { const float* gain = F.in[MODE == 4 ? I_NX : I_NMLP] + col; const f32x4 g0 = *(const GAS f32x4*)gain, g1 = *(const GAS f32x4*)(gain + 4);
#pragma unroll
                for (int e = 0; e < 4; ++e) { v[e] *= g0[e]; v[4 + e] *= g1[e]; }
                *(GAS v4u*)((bf16*)(ws + WS_XN) + row * D + col) = pack8(v); }
            ss = sum8x(ss);
            if ((F.tid & 7) == 0) ssq[(size_t)(MODE == 4 ? 0 : MODE == 7 ? 1 : 2) * M * 16 + row * 16 + tc] = ss;
        } else if (MODE == 5) {
            skinny_tile<D>(F, (const bf16*)(ws + WS_XN) + r0 * D, (const bf16*)(ws + WS_WXQ) + (size_t)c0 * D, v);
            const float rs = row_rs(ssq, (int)row) * 0.0625f;
#pragma unroll
            for (int e = 0; e < 8; ++e) v[e] *= rs;
            *(GAS v4u*)((bf16*)(ws + WS_Q) + row * D + col) = pack8(v);
        } else if (MODE == 8) {
            skinny_tile<D>(F, (const bf16*)(ws + WS_XN) + r0 * D, (const bf16*)(ws + WS_WUP) + (size_t)c0 * D, v);
            const float rs = row_rs(ssq + (size_t)M * 16, (int)row);
#pragma unroll
            for (int e = 0; e < 8; ++e) { const float a = fmaxf(v[e] * rs, 0.f); v[e] = a * a; }
            *(GAS v4u*)((bf16*)(ws + WS_HB) + row * FF + col) = pack8(v);
        }
    }
}

__device__ __forceinline__ void attn_prompt_unit(Frame& F, int u) {
    unsigned char* ws = F.ws; const int lane = F.lane, r = lane & 31, hh = lane >> 5, w = F.wave;
    const int qt = u & 7, head = (u >> 3) & 3, b = u >> 5;
    const size_t row0 = (size_t)b * SEQ + qt * 256 + 32 * w;
    const bf16* Q = (const bf16*)(ws + WS_Q) + (row0 + r) * D + head * 256 + 8 * hh;
    const bf16* Kb = (const bf16*)(ws + WS_KB) + (size_t)b * NMEM * D + head * 256;
    const bf16* Vb = (const bf16*)(ws + WS_VT) + (size_t)head * 256 * MMEM + (size_t)b * NMEM;
    unsigned vofK[8], vofV[8];
#pragma unroll
    for (int k_ = 0; k_ < 8; ++k_) { const int row_ = 16 * (w & 1) + 2 * k_ + (lane >> 5), c_ = (lane & 31) ^ row_; vofK[k_] = (unsigned)(row_ * D + 8 * c_) * 2u; vofV[k_] = (unsigned)(row_ * MMEM + 8 * c_) * 2u; }
#define AT_STAGE(base, stride, vof, half, hbuf) do { const char* ub_ = (const char*)((base) + (size_t)(32 * (4 * (half) + (w >> 1))) * (stride)); _Pragma("unroll") for (int k_ = 0; k_ < 8; ++k_) \
        __builtin_amdgcn_global_load_lds((const unsigned*)(ub_ + (vof)[k_]), (LAS unsigned*)(F.lds + (hbuf) * 65536 + (8 * w + k_) * 1024), 16, 0, 0); } while (0)
#define AT_WAIT(n) asm volatile("s_waitcnt vmcnt(" #n ")" ::: "memory")
#define AT_BAR() do { asm volatile("s_waitcnt lgkmcnt(0)" ::: "memory"); __builtin_amdgcn_s_barrier(); asm volatile("" ::: "memory"); } while (0)
    bf16x8 qf[16];
#pragma unroll
    for (int s2 = 0; s2 < 16; ++s2) qf[s2] = *(const GAS bf16x8*)(Q + 16 * s2);
    asm volatile("s_waitcnt vmcnt(0)" ::: "memory");
    AT_STAGE(Kb, D, vofK, 0, 0); AT_STAGE(Kb, D, vofK, 1, 1);
    f32x16 acc[8];
#pragma unroll
    for (int kt = 0; kt < 8; ++kt)
#pragma unroll
        for (int i = 0; i < 16; ++i) acc[kt][i] = 0.f;
    const LAS unsigned char* rbase = F.lds + r * 512;
    unsigned t16 = (unsigned)((r ^ hh) & 31) << 4;
    AT_WAIT(8); AT_BAR();
#pragma unroll
    for (int kt = 0; kt < 4; ++kt) {
        asm volatile("" : "+v"(t16));
#pragma unroll
        for (int s2 = 0; s2 < 16; ++s2) { acc[kt] = MFMA32(*(const LAS bf16x8*)(rbase + kt * 16384 + (t16 ^ (unsigned)(s2 << 5))), qf[s2], acc[kt]);
            if ((s2 & 3) == 3) asm volatile("" ::: "memory"); }
    }
    AT_BAR();
    AT_STAGE(Vb, MMEM, vofV, 0, 0);
    AT_WAIT(8); AT_BAR();
#pragma unroll
    for (int kt = 4; kt < 8; ++kt) {
        asm volatile("" : "+v"(t16));
#pragma unroll
        for (int s2 = 0; s2 < 16; ++s2) { acc[kt] = MFMA32(*(const LAS bf16x8*)(rbase + 65536 + (kt - 4) * 16384 + (t16 ^ (unsigned)(s2 << 5))), qf[s2], acc[kt]);
            if ((s2 & 3) == 3) asm volatile("" ::: "memory"); }
    }
    AT_BAR();
    AT_STAGE(Vb, MMEM, vofV, 1, 1);
    float mx = -1e30f;
#pragma unroll
    for (int kt = 0; kt < 8; ++kt)
#pragma unroll
        for (int i = 0; i < 16; ++i) mx = fmaxf(mx, acc[kt][i]);
    mx = fmaxf(mx, __shfl_xor(mx, 32));
    float l = 0.f;
#pragma unroll
    for (int kt = 0; kt < 8; ++kt)
#pragma unroll
        for (int i = 0; i < 16; ++i) { const float pv = __builtin_amdgcn_exp2f((acc[kt][i] - mx) * 1.4426950408889634f); acc[kt][i] = pv; l += pv; }
    l += __shfl_xor(l, 32);
    const float il = __builtin_amdgcn_rcpf(l);
    bf16x8 Pb[8][2];
#pragma unroll
    for (int kt = 0; kt < 8; ++kt) { Pb[kt][0] = pack_step(acc[kt], 0); Pb[kt][1] = pack_step(acc[kt], 1); }
    bf16* ctx = (bf16*)(ws + WS_CTX) + (row0 + r) * D + head * 256 + 4 * hh;
    AT_WAIT(8); AT_BAR();
#pragma unroll
    for (int dt = 0; dt < 8; ++dt) {
        if (dt == 4) { AT_WAIT(0); AT_BAR(); }
        f32x16 o;
#pragma unroll
        for (int i = 0; i < 16; ++i) o[i] = 0.f;
        asm volatile("" : "+v"(t16));
#pragma unroll
        for (int kt = 0; kt < 8; ++kt) {
#pragma unroll
            for (int s2 = 0; s2 < 2; ++s2) o = MFMA32(*(const LAS bf16x8*)(rbase + (dt >> 2) * 65536 + (dt & 3) * 16384 + (t16 ^ (unsigned)((2 * kt + s2) << 5))), Pb[kt][s2], o);
            if ((kt & 3) == 3) asm volatile("" ::: "memory"); }
#pragma unroll
        for (int g4 = 0; g4 < 4; ++g4) *(GAS v2u*)(ctx + 32 * dt + 8 * g4) = (v2u){pk2(o[4 * g4] * il, o[4 * g4 + 1] * il), pk2(o[4 * g4 + 2] * il, o[4 * g4 + 3] * il)};
    }
    asm volatile("s_waitcnt vmcnt(0)" ::: "memory");
    AT_BAR();
#undef AT_STAGE
#undef AT_WAIT
#undef AT_BAR
}
__device__ __forceinline__ void attn_sample_pass(Frame& F, int bp) {
    unsigned char* ws = F.ws; const int lane = F.lane, r = lane & 31, hh = lane >> 5;
    const int ul = F.wave >> 2, ds = F.wave & 3, unit = 2 * bp + ul, sb = unit >> 2, head = unit & 3;
    const float* Kc = F.in[I_CK] + (((size_t)sb * NMEM + r) * XH + head) * XD + 64 * ds + 8 * hh;
    const float* Vc = F.in[I_CV] + (((size_t)sb * NMEM) * XH + head) * XD + 64 * ds + r;
    const bf16* Q = (const bf16*)(ws + WS_Q) + ((size_t)MP + (size_t)sb * DS + (r & 7)) * D + head * 256 + 64 * ds + 8 * hh;
    f32x16 acc[8];
#pragma unroll
    for (int kt = 0; kt < 8; ++kt)
#pragma unroll
        for (int i = 0; i < 16; ++i) acc[kt][i] = 0.f;
#pragma unroll
    for (int s2 = 0; s2 < 4; ++s2) {
        bf16x8 bq = *(const GAS bf16x8*)(Q + 16 * s2);
        if (r >= 8) bq = (bf16x8){0, 0, 0, 0, 0, 0, 0, 0};
#pragma unroll
        for (int kt = 0; kt < 8; ++kt) { const float* kp = Kc + (size_t)kt * 32 * XH * XD + 16 * s2; asm volatile("" : "+v"(kp));
            const f32x4 k0 = *(const GAS f32x4*)kp, k1 = *(const GAS f32x4*)(kp + 4);
            const v4u ka = {pk2(k0[0], k0[1]), pk2(k0[2], k0[3]), pk2(k1[0], k1[1]), pk2(k1[2], k1[3])};
            acc[kt] = MFMA32(__builtin_bit_cast(bf16x8, ka), bq, acc[kt]); }
        asm volatile("" ::: "memory");
    }
    LAS float* part = (LAS float*)(F.lds + ul * 32768);
    if (r < 8) {
#pragma unroll
        for (int kt = 0; kt < 8; ++kt)
#pragma unroll
            for (int i = 0; i < 16; ++i) part[(ds * 256 + 32 * kt + crow(i, hh)) * 8 + r] = acc[kt][i];
    }
    __syncthreads();
#pragma unroll
    for (int kt = 0; kt < 8; ++kt)
#pragma unroll
        for (int i = 0; i < 16; ++i) { float sv = 0.f;
            if (r < 8) { const int o = (32 * kt + crow(i, hh)) * 8 + r; sv = (part[o] + part[2048 + o]) + (part[4096 + o] + part[6144 + o]); }
            acc[kt][i] = sv; }
    float mx = -1e30f;
#pragma unroll
    for (int kt = 0; kt < 8; ++kt)
#pragma unroll
        for (int i = 0; i < 16; ++i) mx = fmaxf(mx, acc[kt][i]);
    mx = fmaxf(mx, __shfl_xor(mx, 32));
    float l = 0.f;
#pragma unroll
    for (int kt = 0; kt < 8; ++kt)
#pragma unroll
        for (int i = 0; i < 16; ++i) { const float pv = __expf(acc[kt][i] - mx); acc[kt][i] = pv; l += pv; }
    l += __shfl_xor(l, 32);
    const float il = 1.f / l;
    bf16x8 Pb[8][2];
#pragma unroll
    for (int kt = 0; kt < 8; ++kt) { Pb[kt][0] = pack_step(acc[kt], 0); Pb[kt][1] = pack_step(acc[kt], 1); }
    bf16* ctx = (bf16*)(ws + WS_CTX) + ((size_t)MP + (size_t)sb * DS + (r & 7)) * D + head * 256 + 64 * ds + 4 * hh;
#pragma unroll
    for (int dt = 0; dt < 2; ++dt) {
        f32x16 o;
#pragma unroll
        for (int i = 0; i < 16; ++i) o[i] = 0.f;
#pragma unroll
        for (int kt = 0; kt < 8; ++kt) {
#pragma unroll
            for (int s2 = 0; s2 < 2; ++s2) { float vv[8]; const float* vk = Vc + (size_t)(32 * kt + 16 * s2 + 4 * hh) * XH * XD + 32 * dt; asm volatile("" : "+v"(vk));
#pragma unroll
                for (int j = 0; j < 8; ++j) vv[j] = vk[(size_t)(8 * (j >> 2) + (j & 3)) * XH * XD];
                const v4u va = {pk2(vv[0], vv[1]), pk2(vv[2], vv[3]), pk2(vv[4], vv[5]), pk2(vv[6], vv[7])};
                o = MFMA32(__builtin_bit_cast(bf16x8, va), Pb[kt][s2], o); }
            if ((kt & 3) == 3) asm volatile("" ::: "memory"); }
        if (r < 8) {
#pragma unroll
            for (int g4 = 0; g4 < 4; ++g4) *(GAS v2u*)(ctx + 32 * dt + 8 * g4) = (v2u){pk2(o[4 * g4] * il, o[4 * g4 + 1] * il), pk2(o[4 * g4 + 2] * il, o[4 * g4 + 3] * il)};
        }
    }
    __syncthreads();
}
__device__ __forceinline__ void final_norm_pass(Frame& F) {
    const float* ssq = (const float*)(F.ws + WS_SSQ) + 2 * (size_t)M * 16; float* y = F.out + O_Y;
    const int gw = F.vcu * NWAVES + F.wave, NGW = F.G * NWAVES;
    f32x4 gw4[4];
#pragma unroll
    for (int j = 0; j < 4; ++j) gw4[j] = *(const GAS f32x4*)(F.in[I_NF] + 4 * F.lane + 256 * j);
    for (int m = gw; m < M; m += NGW) { const float rs = row_rs(ssq, m); GAS f32x4* yr = (GAS f32x4*)(y + (size_t)m * D) + F.lane;
#pragma unroll
        for (int j = 0; j < 4; ++j) yr[64 * j] = yr[64 * j] * rs * gw4[j]; }
}

__device__ __forceinline__ void copy_conv_states(Frame& F) {
    const bf16* qkv = (const bf16*)(F.ws + WS_QKV); const bf16* upre = (const bf16*)(F.ws + WS_UPRE);
    const int gt = F.vcu * (NWAVES * 64) + F.tid, NT = F.G * NWAVES * 64;
    const int n1 = (NB + DB) * 3 * 3072;
    for (int e = gt; e < n1; e += NT) { const int c = e % 3072, r = (e / 3072) % 3, s = e / (3 * 3072);
        const size_t row = (s < NB) ? (size_t)s * SEQ + (SEQ - 3 + r) : (size_t)MP + (size_t)(s - NB) * DS + (DS - 3 + r);
        const float v = bf2f(qkv[row * 3072 + c]);
        if (s < NB) F.out[O_GCP + ((size_t)s * 3 + r) * 3072 + c] = v; else F.out[O_GCS + ((size_t)(s - NB) * 3 + r) * 3072 + c] = v; }
    const int n2 = (NB + DB) * 2 * D;
    for (int e = gt; e < n2; e += NT) { const int c = e % D, r = (e / D) % 2, s = e / (2 * D);
        const size_t row = (s < NB) ? (size_t)s * SEQ + (SEQ - 2 + r) : (size_t)MP + (size_t)(s - NB) * DS + (DS - 2 + r);
        const float v = bf2f(upre[row * D + c]);
        if (s < NB) F.out[O_SCP + ((size_t)s * 2 + r) * D + c] = v; else F.out[O_SCS + ((size_t)(s - NB) * 2 + r) * D + c] = v; }
}


#if MK_DEBUG
constexpr int CW_CHK = 512;
__device__ __forceinline__ unsigned hash_u(unsigned x) { x ^= x >> 16; x *= 0x7feb352du; x ^= x >> 15; x *= 0x846ca68bu; x ^= x >> 16; return x; }
__device__ __forceinline__ void chk_put(Frame& F, int ch, float got, float ref, float floor_) {
    float e = (got - ref) * (got - ref); if (!(e == e) || e > 1e30f) e = 1e30f;
    atomicAdd((float*)(F.ctl + CW_CHK + 2 * ch), e); atomicAdd((float*)(F.ctl + CW_CHK + 2 * ch + 1), ref * ref);
}
__device__ __forceinline__ float bfround(float x) { return bflo(pk2(x, 0.f) & 0xffffu); }
#if 0
__device__ __forceinline__ void debug_checks(Frame& F) {
    const unsigned gt = (unsigned)(F.vcu * (NWAVES * 64) + F.tid);
    unsigned char* ws = F.ws;
    const bf16* win = (const bf16*)(ws + WS_WIN); const bf16* xn = (const bf16*)(ws + WS_XN); const bf16* mn = (const bf16*)(ws + WS_MN);
    const bf16* wxkv = (const bf16*)(ws + WS_WXKV);
    { const unsigned h = hash_u(gt * 3u + 1u); const int n = h % NIN_T, k = (h >> 16) % D;
      chk_put(F, 0, bf2f(win[(size_t)n * D + k]), bfround(F.in[I_WIN][(size_t)k * NIN + win_src_col(n)]), 1e-6f);
      const int n2 = h % 2048; chk_put(F, 0, bf2f(wxkv[(size_t)n2 * D + k]), bfround(F.in[I_WXKV][(size_t)k * 2048 + n2]), 1e-6f);
      const int n3 = h % 1024, k3 = (h >> 12) % FF; chk_put(F, 0, bf2f(((const bf16*)(ws + WS_WDN))[(size_t)n3 * FF + k3]), bfround(F.in[I_WDN][(size_t)k3 * D + n3]), 1e-6f);
      const int n4 = h % FF; chk_put(F, 0, bf2f(((const bf16*)(ws + WS_WUP))[(size_t)n4 * D + k]), bfround(F.in[I_WUP][(size_t)k * FF + n4]), 1e-6f);
      chk_put(F, 0, bf2f(((const bf16*)(ws + WS_WXO))[(size_t)n3 * D + k]), bfround(F.in[I_WXO][(size_t)k * D + n3]), 1e-6f);
      chk_put(F, 0, bf2f(((const bf16*)(ws + WS_WGDNO))[(size_t)n3 * D + k]), bfround(F.in[I_WGDNO][(size_t)k * D + n3]), 1e-6f); }
    if (gt < 4096) { const unsigned h = hash_u(gt * 7u + 5u); const int m = h % M; const float* xr = (m < MP) ? F.in[I_XP] + (size_t)m * D : F.in[I_XS] + (size_t)(m - MP) * D;
      float s = 0.f; for (int k = 0; k < D; ++k) s += xr[k] * xr[k]; const float rs = 1.f / sqrtf(s / D + EPS); const int k0 = (h >> 16) % D;
      chk_put(F, 1, bf2f(xn[(size_t)m * D + k0]), xr[k0] * rs * F.in[I_NMIX][k0], 1e-3f);
      const int o = (h >> 8) & 15; float a = 0.f; for (int k = 0; k < D; ++k) a += xr[k] * rs * F.in[I_NMIX][k] * F.in[I_WIN][(size_t)k * NIN + 4096 + o];
      chk_put(F, 2, ((const float*)(ws + WS_AB))[(size_t)m * 16 + o], a, 1e-2f);
      const int mm = h % MMEM; const float* mr = F.in[I_MEM] + (size_t)mm * D; s = 0.f; for (int k = 0; k < D; ++k) s += mr[k] * mr[k]; const float rs2 = 1.f / sqrtf(s / D + EPS);
      chk_put(F, 1, bf2f(mn[(size_t)mm * D + k0]), mr[k0] * rs2 * F.in[I_NMEM][k0], 1e-3f); }
    if (gt < 16384) { const unsigned h = hash_u(gt * 11u + 3u); const int m = h % M, n = (h >> 9) % NIN_T;
      float d = 0.f; for (int k = 0; k < D; ++k) d += bf2f(xn[(size_t)m * D + k]) * bf2f(win[(size_t)n * D + k]);
      const int pn = n >> 8, c = n & 255;
      if (pn < 12) chk_put(F, 3, bf2f(((const bf16*)(ws + WS_QKV))[(size_t)m * 3072 + n]), d, 2e-2f);
      else if (pn < 16) chk_put(F, 4, bf2f(((const bf16*)(F.out + O_Y))[(size_t)m * D + (n - 3072)]), d / (1.f + expf(-d)), 2e-2f);
      else if (pn < 20) chk_put(F, 4, bf2f((((const bf16*)(F.out + O_Y)) + (size_t)M * D)[(size_t)m * D + (n - 4096)]), d, 2e-2f);
      else if (pn < 28) { const int n2 = (c < 128) ? n + 128 : n - 128; float d2 = 0.f; for (int k = 0; k < D; ++k) d2 += bf2f(xn[(size_t)m * D + k]) * bf2f(win[(size_t)n2 * D + k]);
          chk_put(F, 5, bf2f(((const bf16*)(ws + WS_UPRE))[(size_t)m * D + 128 * (pn - 20) + (c & 127)]), d * d2, 2e-2f); }
      else if (pn < 32) chk_put(F, 4, bf2f(((const bf16*)(ws + WS_SGA))[(size_t)m * D + (n - 7168)]), 1.f / (1.f + expf(-d)), 2e-2f);
      else chk_put(F, 4, bf2f(((const bf16*)(ws + WS_SGB))[(size_t)m * D + (n - 8192)]), 1.f / (1.f + expf(-d)), 2e-2f);
      const int mm = h % MMEM, nn = (h >> 11) % 2048; float dk = 0.f; for (int k = 0; k < D; ++k) dk += bf2f(mn[(size_t)mm * D + k]) * bf2f(wxkv[(size_t)nn * D + k]);
      if (nn < 1024) { chk_put(F, 6, F.out[O_MK + (size_t)mm * D + nn], dk, 2e-2f); chk_put(F, 6, bf2f(((const bf16*)(ws + WS_KB))[(size_t)mm * D + nn]), dk, 2e-2f); }
      else { chk_put(F, 6, F.out[O_MV + (size_t)mm * D + (nn - 1024)], dk, 2e-2f);
          const int key = mm & 255, kp = (key & ~12) | ((key & 4) << 1) | ((key & 8) >> 1);
          chk_put(F, 7, bf2f(((const bf16*)(ws + WS_VT))[(size_t)(nn - 1024) * MMEM + (mm & ~255) + kp]), dk, 2e-2f); } }
}

#endif
__device__ __forceinline__ void debug_checks(Frame& F) {
    const unsigned gt = (unsigned)(F.vcu * (NWAVES * 64) + F.tid);
    unsigned char* ws = F.ws;
    if (gt < 512) { const int idx = gt >> 3, hd = gt & 7; const int m = hash_u(idx * 29u + 11u) % M; const bf16* og = (const bf16*)(ws + WS_O); const bf16* sz = (const bf16*)(F.out + O_Y);
        const bf16* osv = (const bf16*)(ws + WS_END - 2 * MiB) + (size_t)idx * D + hd * 128;
        float ss = 0.f; for (int dv = 0; dv < 128; ++dv) { const float o = bf2f(osv[dv]); ss += o * o; } const float rs = 1.f / sqrtf(ss / 128.f + EPS);
        for (int dv = 0; dv < 128; ++dv) chk_put(F, 1, bf2f(og[(size_t)m * D + hd * 128 + dv]), bf2f(osv[dv]) * rs * F.in[I_GON][dv] * bf2f(sz[(size_t)m * D + hd * 128 + dv]), 0.f); }
    if (gt < 16384) { const unsigned h = hash_u(gt * 11u + 3u); const int m = h % M, c = (h >> 15) % D; const bf16* xn0 = nullptr; (void)xn0;
        const bf16* upre = (const bf16*)(ws + WS_UPRE); const bf16* ub = (const bf16*)(F.out + O_Y) + (size_t)M * D;
        const bool smp = m >= MP; const int t = smp ? ((m - MP) & 7) : (m & (SEQ - 1)); const int sb = smp ? ((m - MP) >> 3) : 0;
        float conv = 0.f; for (int k = 0; k < 3; ++k) { const int tt = t - 2 + k; float xv = 0.f; if (tt >= 0) xv = bf2f(upre[(size_t)(m - 2 + k) * D + c]); else if (smp) xv = F.in[I_SSC][((size_t)sb * 2 + (2 + tt)) * D + c]; conv += F.in[I_SCW][(size_t)k * D + c] * xv; }
        const float* xr = (m < MP) ? F.in[I_XP] + (size_t)m * D : F.in[I_XS] + (size_t)(m - MP) * D; float ss = 0.f; for (int k = 0; k < D; ++k) ss += xr[k] * xr[k]; const float rs = 1.f / sqrtf(ss / D + EPS);
        float bgv = 0.f; for (int k = 0; k < D; ++k) bgv += xr[k] * rs * F.in[I_NMIX][k] * F.in[I_WIN][(size_t)k * NIN + 4112 + c];
        chk_put(F, 2, bf2f(ub[(size_t)m * D + c]), bgv * conv, 3e-2f); }
}
__device__ __forceinline__ void naive_gdn_col(Frame& F, size_t rowb, int T, const float* hist, const float* S0  , int h, int dv, float* Scol  , int ch, bool check_o) {
    const bf16* qkv = (const bf16*)(F.ws + WS_QKV); const float* gcw = F.in[I_GCW]; const bf16* Og = (const bf16*)(F.ws + WS_O);
    for (int dk = 0; dk < 128; ++dk) Scol[dk] = S0 ? S0[(size_t)dk * 128 + dv] : 0.f;
    const float eA = expf(F.in[I_ALOG][h]), dtb = F.in[I_DTB][h];
    for (int t = 0; t < T; ++t) {
        float ssk = 0.f, ssq = 0.f, kS = 0.f;
        for (int pass = 0; pass < 2; ++pass) {
            float o = 0.f, rk = 0.f, rq = 0.f, uu = 0.f, eg = 0.f;
            if (pass == 1) {
                rk = 1.f / sqrtf(ssk + 1e-6f); rq = 1.f / sqrtf(ssq + 1e-6f) * 0.08838834764831845f;
                const float* ab = (const float*)(F.ws + WS_AB) + (rowb + t) * 16;
                const float g = -eA * log1pf(expf(ab[h] + dtb)); eg = expf(g); const float beta = 1.f / (1.f + expf(-ab[8 + h]));
                float vv = 0.f; { const int col = 2048 + h * 128 + dv; for (int i = 0; i < 4; ++i) { const int tt = t - 3 + i; const float xv = (tt >= 0) ? bf2f(qkv[(rowb + tt) * 3072 + col]) : (hist ? hist[(size_t)(3 + tt) * 3072 + col] : 0.f); vv += gcw[(size_t)i * 3072 + col] * xv; } vv = vv / (1.f + expf(-vv)); }
                uu = beta * (vv - eg * kS * rk);
            }
            for (int dk = 0; dk < 128; ++dk) {
                float kv = 0.f, qv = 0.f;
                for (int i = 0; i < 4; ++i) { const int tt = t - 3 + i; const int ck = 1024 + h * 128 + dk, cq = h * 128 + dk;
                    const float xk = (tt >= 0) ? bf2f(qkv[(rowb + tt) * 3072 + ck]) : (hist ? hist[(size_t)(3 + tt) * 3072 + ck] : 0.f);
                    const float xq = (tt >= 0) ? bf2f(qkv[(rowb + tt) * 3072 + cq]) : (hist ? hist[(size_t)(3 + tt) * 3072 + cq] : 0.f);
                    kv += gcw[(size_t)i * 3072 + ck] * xk; qv += gcw[(size_t)i * 3072 + cq] * xq; }
                kv = kv / (1.f + expf(-kv)); qv = qv / (1.f + expf(-qv));
                if (pass == 0) { ssk += kv * kv; ssq += qv * qv; kS += Scol[dk] * kv; }
                else { Scol[dk] = eg * Scol[dk] + kv * rk * uu; o += Scol[dk] * qv * rq; }
            }
            if (pass == 1 && check_o && (t % 61 == 0 || t == T - 1)) chk_put(F, ch - 5, bf2f(Og[(rowb + t) * D + h * 128 + dv]), o, 2e-2f);
        }
    }
}
__device__ __forceinline__ void debug_checks_gdn(Frame& F) {
    float* scr = (float*)(F.ws + WS_END - 4 * MiB);
    const unsigned gt = (unsigned)(F.vcu * (NWAVES * 64) + F.tid);
    if (gt < 64) {
        const unsigned hsh = hash_u(gt * 13u + 7u); const int b = hsh % DB, h = (hsh >> 8) & 7, dv = (hsh >> 12) & 127;
        float* Scol = scr + (size_t)gt * 128;
        naive_gdn_col(F, (size_t)MP + (size_t)b * DS, DS, F.in[I_SGC] + (size_t)b * 3 * 3072, F.in[I_SG] + (size_t)(b * 8 + h) * 128 * 128, h, dv, Scol, 8, true);
        for (int dk = 0; dk < 128; ++dk) chk_put(F, 8, F.out[O_GSS + ((size_t)(b * 8 + h) * 128 + dk) * 128 + dv], Scol[dk], 1e-3f);
    } else if (gt >= 1024 && gt < 1024 + 64) {
        const int idx = gt - 1024; const int m = hash_u(idx * 29u + 11u) % M; const bf16* Og = (const bf16*)(F.ws + WS_O); bf16* osv = (bf16*)(F.ws + WS_END - 2 * MiB) + (size_t)idx * D;
        for (int k = 0; k < D; ++k) osv[k] = Og[(size_t)m * D + k];
    } else if (gt >= 512 && gt < 512 + 32) {
        const unsigned hsh = hash_u(gt * 17u + 3u); const int b = hsh % NB, h = (hsh >> 8) & 7, dv = (hsh >> 12) & 127;
        float* Scol = scr + (size_t)(gt - 512 + 64) * 128;
        naive_gdn_col(F, (size_t)b * SEQ, SEQ, nullptr, nullptr, h, dv, Scol, 9, true);
        for (int dk = 0; dk < 128; ++dk) chk_put(F, 9, F.out[O_GSP + ((size_t)(b * 8 + h) * 128 + dk) * 128 + dv], Scol[dk], 1e-3f);
    }
}
__device__ __forceinline__ void debug_report(Frame& F) {
    const size_t osz[10] = {(size_t)MP * D, (size_t)MS * D, (size_t)MMEM * D, (size_t)MMEM * D, (size_t)NB * 3 * 3072, (size_t)NB * NH * DK * DK, (size_t)NB * 2 * D, (size_t)DB * 3 * 3072, (size_t)DB * NH * DK * DK, (size_t)DB * 2 * D};
    const size_t gt = (size_t)F.vcu * (NWAVES * 64) + F.tid, NT = (size_t)F.G * NWAVES * 64; size_t off = 0;
    for (int c = 0; c < 10; ++c) {
        const float num = __uint_as_float(__hip_atomic_load(F.ctl + CW_CHK + 2 * c, RLX_AGENT)), den = __uint_as_float(__hip_atomic_load(F.ctl + CW_CHK + 2 * c + 1, RLX_AGENT));
        int cnt = (den <= 0.f) ? 99 : (num <= 0.f) ? 98 : (int)(10.f - 10.f * log10f(num / den) + 0.5f); cnt = cnt < 10 ? 10 : (cnt > 97 ? 97 : cnt);
        for (size_t i = gt; i < osz[c]; i += NT) F.out[off + i] = (i < (size_t)cnt) ? __uint_as_float(0xAAAAAAAAu) : 1.0f;
        off += osz[c];
    }
}
#endif

constexpr int PH_P2C = 4 + MK_DEBUG, PH_P3 = PH_P2C + 1, PH_P4 = PH_P3 + 1, PH_P5 = PH_P4 + 1, PH_P6 = PH_P5 + 1, PH_P7 = PH_P6 + 1, PH_P8 = PH_P7 + 1, PH_P9 = PH_P8 + 1, PH_P10 = PH_P9 + 1, PH_LAST = PH_P10;
constexpr int N_PHASES = PH_LAST + 1 + 2 * MK_DEBUG;
__global__ void __launch_bounds__(NWAVES * 64, 2) mk_fwd(Args args) {
    extern __shared__ __attribute__((aligned(16))) unsigned char lds[];
    Frame F;
    F.lds = (LAS unsigned char*)lds;
    F.MISC = (volatile LAS unsigned*)(F.lds + MISC_OFF);
    F.tid = threadIdx.x; F.lane = F.tid & 63; F.wave = __builtin_amdgcn_readfirstlane(F.tid >> 6);
    F.G = gridDim.x; { const int bx = blockIdx.x; F.vcu = (F.G % 8 == 0) ? (bx % 8) * (F.G / 8) + bx / 8 : bx; }
    F.in = args.in; F.out = args.out; F.ws = args.ws;
    F.ctl = (gu32*)(args.ws + WS_CTL);
    for (int u = F.tid; u < (LDS_BYTES - LDSCTL_OFF) / 4; u += NWAVES * 64) ((LAS unsigned*)(F.lds + LDSCTL_OFF))[u] = 0u;
    __syncthreads();
    XcdBarrier bar = xcd_barrier_post((unsigned*)(F.ctl + CW_BAR) + args.li * XCD_BAR_WORDS, F.MISC + 8);
    const int lo = args.ph_lo, hi = args.ph_hi;
#define IN(k) (lo <= (k) && (k) < hi)
#define BOTH(k) (IN(k) && IN((k) + 1))
#define GRID_BAR() xcd_barrier(bar)
#if MK_TIMING
    int n_stamp = 0;
#define STAMP() do { if (blockIdx.x == 0 && F.tid == 0) __hip_atomic_store(F.ctl + 1024 + 2 * n_stamp, (unsigned)(__builtin_amdgcn_s_memrealtime()), RLX_AGENT); ++n_stamp; } while (0)
#define SUBSTAMP(k) do { if (blockIdx.x == 0 && F.tid == 0) __hip_atomic_store(F.ctl + 1024 + 2 * (20 + (k)), (unsigned)(__builtin_amdgcn_s_memrealtime()), RLX_AGENT); } while (0)
#else
#define STAMP() do {} while (0)
#define SUBSTAMP(k) do {} while (0)
#endif
    STAMP();
    unsigned char* ws = args.ws;

    if (IN(0)) { p0_prologue(F); if (BOTH(0)) GRID_BAR(); STAMP(); }

    if (IN(1)) {
        LAS unsigned* tab = (LAS unsigned*)(F.lds + TAB_OFF);
        if (F.tid == 0) {
            tab[16] = 0u; tab[17] = 0u; tab[18] = 0u;
            tab[0] = (unsigned)WS_XN; tab[4] = (unsigned)WS_WIN; tab[8] = M / 256; tab[12] = NIN_T / 256;
            tab[1] = (unsigned)WS_MN; tab[5] = (unsigned)WS_WXKV; tab[9] = MMEM / 256; tab[13] = 8;
            tab[2] = (unsigned)(WS_WXKV + (size_t)D * D * 2); tab[6] = (unsigned)WS_MN; tab[10] = D / 256; tab[14] = MMEM / 256; }
        __syncthreads();
        pg8::Probs P{ws, tab, 3, D};
        pg8::GroupOrder S; S.init(P, F.G, (int)blockIdx.x);
        EpiP1 E{ws, F.out};
        pg8::gemm_phase<EpiP1, pg8::GroupOrder>(F.lds + RING_OFF, P, S, E);
        if (BOTH(1)) GRID_BAR(); STAMP();
    }

    if (IN(2)) {
        SUBSTAMP(0);
        for (int pu = F.vcu; pu < NB * NH * 16; pu += F.G) gdn_prep_unit(F, pu);
        SUBSTAMP(1);
        SUBSTAMP(2);
        sc_conv_pass(F);
        SUBSTAMP(3);
        copy_conv_states(F);
        SUBSTAMP(4);
        if (BOTH(2)) GRID_BAR(); STAMP();
    }
    if (IN(3)) {
        const int nA = (F.G >= 4 * NB * NH) ? NB * NH : 0;
        const bool roleA = nA && (F.vcu & 3) == 0 && (F.vcu >> 2) < nA;
        if (!nA) { for (int bh = F.vcu; bh < NB * NH; bh += F.G) gdn_scan_unit(F, bh); }
        else if (roleA) gdn_scan_unit(F, F.vcu >> 2);
        if (!roleA) {
            const int nB = nA ? F.G - nA : F.G, jB = nA ? F.vcu - ((F.vcu >> 2) < nA ? (F.vcu >> 2) + 1 : nA) : F.vcu;
            for (int su = jB, i2 = 0; su < DB * NH / 4; ++i2, su = nB * i2 + ((jB + nB - (nB / 3) * i2) % nB)) gdn_sample_unit(F, su);
            LAS unsigned* tab2 = (LAS unsigned*)(F.lds + TAB_OFF);
            __syncthreads();
            if (F.tid == 0) { const long long ua = (long long)((unsigned char*)(F.out + O_Y) - ws) + (long long)M * D * 2;
                tab2[0] = (unsigned)(unsigned long long)ua; tab2[16] = (unsigned)((unsigned long long)ua >> 32); tab2[4] = (unsigned)WS_WSCO; tab2[8] = MP / 256; tab2[12] = 4; }
            __syncthreads();
            pg8::Probs P{ws, tab2, 1, D}; pg8::GroupOrder S; S.init(P, nB, jB);
            EpiP3 E{ws, 0};
            pg8::gemm_phase<EpiP3, pg8::GroupOrder>(F.lds + RING_OFF, P, S, E);
        }
        if (BOTH(3)) GRID_BAR(); STAMP();
    }
#if MK_DEBUG
    if (IN(4)) { debug_checks_gdn(F); }
#endif
    if (IN(PH_P2C)) { og_pass(F); if (BOTH(PH_P2C)) GRID_BAR(); STAMP(); }
    LAS unsigned* tab = (LAS unsigned*)(F.lds + TAB_OFF);
    float* const ssq = (float*)(ws + WS_SSQ);
#define SET_TAB1(oa, ob, nm, nn) do { __syncthreads(); if (F.tid == 0) { tab[0] = (unsigned)(oa); tab[16] = 0u; tab[4] = (unsigned)(ob); tab[8] = (nm); tab[12] = (nn); } __syncthreads(); } while (0)
    if (IN(PH_P3)) { SUBSTAMP(10);
        __syncthreads();
        if (F.tid == 0) { tab[0] = (unsigned)WS_O; tab[16] = 0u; tab[4] = (unsigned)WS_WGDNO; tab[8] = MP / 256; tab[12] = 4; }
        __syncthreads();
        pg8::Probs P{ws, tab, 1, D}; pg8::GroupOrder S; S.init(P, F.G, (int)blockIdx.x);
        EpiP3 E{ws, 1};
        pg8::gemm_phase<EpiP3, pg8::GroupOrder>(F.lds + RING_OFF, P, S, E);
        SUBSTAMP(11);
        skinny_phase<3>(F);
        SUBSTAMP(12);
        if (BOTH(PH_P3)) GRID_BAR(); STAMP();
    }
    if (IN(PH_P4)) { SUBSTAMP(14);
        SET_TAB1(WS_MG, WS_WMIX, MP / 256, 4);
        pg8::Probs P{ws, tab, 1, D}; pg8::GroupOrder S; S.init(P, F.G, (int)blockIdx.x);
        EpiRes<true> E{F.in[I_XP], F.in[I_XS], F.out + O_Y, F.in[I_NX], (bf16*)(ws + WS_XN), ssq, true};
        pg8::gemm_phase<EpiRes<true>, pg8::GroupOrder>(F.lds + RING_OFF, P, S, E);
        SUBSTAMP(15);
        skinny_phase<4>(F);
        SUBSTAMP(16);
        if (BOTH(PH_P4)) GRID_BAR(); STAMP();
    }
    if (IN(PH_P5)) { SUBSTAMP(18);
        SET_TAB1(WS_XN, WS_WXQ, MP / 256, 4);
        pg8::Probs P{ws, tab, 1, D}; pg8::GroupOrder S; S.init(P, F.G, (int)blockIdx.x);
        EpiScale<0> E{ssq, (bf16*)(ws + WS_Q), D, 0.0625f};
        pg8::gemm_phase<EpiScale<0>, pg8::GroupOrder>(F.lds + RING_OFF, P, S, E);
        SUBSTAMP(19);
        skinny_phase<5>(F);
        SUBSTAMP(20);
        if (BOTH(PH_P5)) GRID_BAR(); STAMP();
    }
    if (IN(PH_P6)) {
        for (int u = F.vcu; u < NB * XH * 8; u += F.G) attn_prompt_unit(F, u);
        for (int bp = F.vcu; bp < DB * XH / 2; bp += F.G) attn_sample_pass(F, bp);
        if (BOTH(PH_P6)) GRID_BAR(); STAMP();
    }
    if (IN(PH_P7)) {
        SET_TAB1(WS_CTX, WS_WXO, MP / 256, 4);
        pg8::Probs P{ws, tab, 1, D}; pg8::GroupOrder S; S.init(P, F.G, (int)blockIdx.x);
        EpiRes<false> E{nullptr, nullptr, F.out + O_Y, F.in[I_NMLP], (bf16*)(ws + WS_XN), ssq + (size_t)M * 16, true};
        pg8::gemm_phase<EpiRes<false>, pg8::GroupOrder>(F.lds + RING_OFF, P, S, E);
        skinny_phase<7>(F);
        if (BOTH(PH_P7)) GRID_BAR(); STAMP();
    }
    if (IN(PH_P8)) { SUBSTAMP(22);
        SET_TAB1(WS_XN, WS_WUP, MP / 256, FF / 256);
        pg8::Probs P{ws, tab, 1, D}; pg8::GroupOrder S; S.init(P, F.G, (int)blockIdx.x);
        EpiScale<1> E{ssq + (size_t)M * 16, (bf16*)(ws + WS_HB), FF, 1.f};
        pg8::gemm_phase<EpiScale<1>, pg8::GroupOrder>(F.lds + RING_OFF, P, S, E);
        SUBSTAMP(23);
        skinny_phase<8>(F);
        SUBSTAMP(24);
        if (BOTH(PH_P8)) GRID_BAR(); STAMP();
    }
    if (IN(PH_P9)) { SUBSTAMP(26);
        SET_TAB1(WS_HB, WS_WDN, MP / 256, 4);
        pg8::Probs P{ws, tab, 1, FF}; pg8::GroupOrder S; S.init(P, F.G, (int)blockIdx.x);
        EpiRes<false> E{nullptr, nullptr, F.out + O_Y, F.in[I_NF], nullptr, ssq + 2 * (size_t)M * 16, false};
        pg8::gemm_phase<EpiRes<false>, pg8::GroupOrder>(F.lds + RING_OFF, P, S, E);
        SUBSTAMP(27);
        skinny_phase<9>(F);
        SUBSTAMP(28);
        if (BOTH(PH_P9)) GRID_BAR(); STAMP();
    }
    if (IN(PH_P10)) { final_norm_pass(F); }
#if MK_TIMING
    GRID_BAR(); STAMP();
    {
        const size_t osz[10] = {(size_t)MP * D, (size_t)MS * D, (size_t)MMEM * D, (size_t)MMEM * D, (size_t)NB * 3 * 3072, (size_t)NB * NH * DK * DK, (size_t)NB * 2 * D, (size_t)DB * 3 * 3072, (size_t)DB * NH * DK * DK, (size_t)DB * 2 * D};
#if MK_TIMING == 3
        const int s0[10] = {30, 31, 34, 35, 38, 39, 42, 43, 50, 51}, s1[10] = {31, 32, 35, 36, 39, 40, 43, 44, 51, 52};
#elif MK_TIMING == 1
        const int s0[10] = {0, 1, 2, 3, 4, 5, 6, 8, 9, 11}, s1[10] = {1, 2, 3, 4, 5, 6, 8, 9, 11, 13};
#else
        const int s0[10] = {25, 26, 27, 28, 29, 25, 9, 10, 11, 12}, s1[10] = {26, 27, 28, 29, 30, 30, 10, 11, 12, 13};
#endif
        const size_t gt = (size_t)F.vcu * (NWAVES * 64) + F.tid, NT = (size_t)F.G * NWAVES * 64; size_t off = 0;
        for (int c = 0; c < 10; ++c) {
            const unsigned t0 = __hip_atomic_load(F.ctl + 1024 + 2 * s0[c], RLX_AGENT), t1 = __hip_atomic_load(F.ctl + 1024 + 2 * s1[c], RLX_AGENT);
            int cnt = (c < 6 && MK_TIMING == 2) ? (int)((t1 - t0) / 10u) : (int)((t1 - t0) / 100u); cnt = cnt < 1 ? 1 : cnt;
            for (size_t i = gt; i < osz[c]; i += NT) F.out[off + i] = (i < (size_t)cnt) ? __uint_as_float(0xAAAAAAAAu) : 1.0f;
            off += osz[c];
        }
    }
#endif
#if MK_DEBUG
    if (IN(N_PHASES - 2)) { debug_checks(F); if (BOTH(N_PHASES - 2)) GRID_BAR(); }
    if (IN(N_PHASES - 1)) { debug_report(F); }
#endif
#undef IN
#undef BOTH
}

#ifndef MK_ONE_LAUNCH
#define MK_ONE_LAUNCH 1
#endif
extern "C" void kernel_launch(void* const* d_in, const int* in_sizes, int n_in, void* d_out, int out_size, void* d_ws, size_t ws_size, hipStream_t stream) {
    static int grid = 0;
    if (grid == 0) {
        if (n_in != 27 || out_size != (int)O_END || ws_size < WS_END) { fprintf(stderr, "kernel_launch: unexpected shapes: n_in %d out %d ws %zu (need %zu)\n", n_in, out_size, ws_size, (size_t)WS_END); grid = -1; return; }
        int dev = 0, cus = 0;
        if (hipGetDevice(&dev) != hipSuccess || hipDeviceGetAttribute(&cus, hipDeviceAttributeMultiprocessorCount, dev) != hipSuccess) { grid = -1; return; }
        if (hipFuncSetAttribute((const void*)mk_fwd, hipFuncAttributeMaxDynamicSharedMemorySize, LDS_BYTES) != hipSuccess) { fprintf(stderr, "kernel_launch: hipFuncSetAttribute failed\n"); grid = -1; return; }
        int per_cu = 0;
        (void)hipOccupancyMaxActiveBlocksPerMultiprocessor(&per_cu, (const void*)mk_fwd, NWAVES * 64, LDS_BYTES);
        (void)hipGetLastError();
        grid = cus;
    }
    if (grid < 0) return;
    (void)hipMemsetAsync((char*)d_ws + WS_CTL, 0, CTL_ZERO_BYTES, stream);
    Args a{};
    for (int i = 0; i < 27; ++i) a.in[i] = (const float*)d_in[i];
    a.out = (float*)d_out; a.ws = (unsigned char*)d_ws;
#if MK_ONE_LAUNCH
    a.ph_lo = 0; a.ph_hi = N_PHASES; a.li = 0;
    hipLaunchKernelGGL(mk_fwd, dim3(grid), dim3(NWAVES * 64), LDS_BYTES, stream, a);
#else
    for (int p = 0; p < N_PHASES; ++p) { a.ph_lo = p; a.ph_hi = p + 1; a.li = p;
        hipLaunchKernelGGL(mk_fwd, dim3(grid), dim3(NWAVES * 64), LDS_BYTES, stream, a); }
#endif
}
```
